# Optimizing an MI355X kernel written in HIP

```python
import jax, jax.numpy as jnp
from jax import lax
import numpy as np

D_MODEL = 1024
BATCH = 2
SEQ = 8192
DEPTH = 1

N_HEADS = 8
HEAD_DIM = 64
ATTN_WIDTH = N_HEADS * HEAD_DIM
Q_BLOCK = 128
CONV_WIDTH = D_MODEL // 2
CONV_KERNEL = 31
N_EXPERTS = 32
TOP_K = 4
D_EXPERT = D_MODEL
SWIGLU_LIMIT = 7.0
SWIGLU_ALPHA = 1.702
MOE_BLOCK = 128
RMS_EPS = 1e-5
LN_EPS = 1e-5
N_MOD = 6
COL_SIZES = (CONV_WIDTH, CONV_WIDTH,
             ATTN_WIDTH, ATTN_WIDTH, ATTN_WIDTH,
             N_HEADS,
             D_MODEL, D_MODEL)
IN_COLS = sum(COL_SIZES)

kernel_name = "hybrid_conv_fox_moe_block"


def rms_norm(x, g):
    xf = x.astype(jnp.float32)
    y = xf * lax.rsqrt(jnp.mean(xf * xf, axis=-1, keepdims=True) + RMS_EPS)
    return (y * g.astype(jnp.float32)).astype(x.dtype)


def layer_norm(x, g, b):
    xf = x.astype(jnp.float32)
    mu = jnp.mean(xf, axis=-1, keepdims=True)
    var = jnp.mean(jnp.square(xf - mu), axis=-1, keepdims=True)
    y = (xf - mu) * lax.rsqrt(var + LN_EPS)
    return (y * g.astype(jnp.float32) + b.astype(jnp.float32)).astype(x.dtype)


def conv_module(u_val, u_gate, conv_w, conv_b, ln_g, ln_b, w_proj):
    a = u_val * jax.nn.sigmoid(u_gate)
    a = lax.conv_general_dilated(
        a, conv_w[:, None, :].astype(a.dtype), window_strides=(1,),
        padding=[(CONV_KERNEL - 1, 0)],
        dimension_numbers=('NWC', 'WIO', 'NWC'),
        feature_group_count=CONV_WIDTH) + conv_b
    a = jax.nn.silu(layer_norm(a, ln_g, ln_b))
    return a @ w_proj


def forgetting_attention(q, k, v, f_logit):
    B, S = q.shape[0], q.shape[1]
    n_blocks = S // Q_BLOCK
    log_f = jax.nn.log_sigmoid(f_logit.astype(jnp.float32))
    F = jnp.cumsum(log_f, axis=1).transpose(0, 2, 1)
    kh = k.transpose(0, 2, 1, 3)
    vh = v.transpose(0, 2, 1, 3)
    q_blocks = q.transpose(0, 2, 1, 3).reshape(B, N_HEADS, n_blocks, Q_BLOCK, HEAD_DIM).transpose(2, 0, 1, 3, 4)
    F_blocks = F.reshape(B, N_HEADS, n_blocks, Q_BLOCK).transpose(2, 0, 1, 3)
    k_pos = jnp.arange(S)
    scale = HEAD_DIM ** -0.5

    def one_block(args):
        qi, Fi, bi = args
        q_pos = bi * Q_BLOCK + jnp.arange(Q_BLOCK)
        s = jnp.einsum('bhqd,bhkd->bhqk', qi, kh).astype(jnp.float32) * scale
        s = s + Fi[..., :, None] - F[:, :, None, :]
        s = jnp.where(k_pos[None, :] <= q_pos[:, None], s, -jnp.inf)
        p = jax.nn.softmax(s, axis=-1)
        return jnp.einsum('bhqk,bhkd->bhqd', p.astype(vh.dtype), vh)

    out = lax.map(one_block, (q_blocks, F_blocks, jnp.arange(n_blocks)))
    return out.transpose(1, 0, 3, 2, 4).reshape(B, S, ATTN_WIDTH)


def moe_ffn(h, w_router, b_router, w1, b1, w2, b2):
    B, S, D = h.shape
    T = B * S
    A = T * TOP_K
    hf = h.reshape(T, D)
    logits = (hf @ w_router + b_router).astype(jnp.float32)
    top_v, top_e = lax.top_k(logits, TOP_K)
    gates = jax.nn.softmax(top_v, axis=-1)

    flat_e = top_e.reshape(A).astype(jnp.int32)
    flat_tok = (jnp.arange(A, dtype=jnp.int32) // TOP_K)
    flat_gate = gates.reshape(A)
    order = jnp.argsort(flat_e)
    se, stok, sg = flat_e[order], flat_tok[order], flat_gate[order]
    counts = jnp.bincount(flat_e, length=N_EXPERTS)
    padded = (counts + MOE_BLOCK - 1) // MOE_BLOCK * MOE_BLOCK
    pend = jnp.cumsum(padded)
    pstart = pend - padded
    ustart = jnp.cumsum(counts) - counts
    dest = pstart[se] + jnp.arange(A, dtype=jnp.int32) - ustart[se]
    P = A + N_EXPERTS * MOE_BLOCK
    n_blocks = P // MOE_BLOCK
    tok_buf = jnp.zeros((P,), jnp.int32).at[dest].set(stok)
    gate_buf = jnp.zeros((P,), jnp.float32).at[dest].set(sg)
    block_e = jnp.clip(jnp.searchsorted(pend, jnp.arange(n_blocks) * MOE_BLOCK, side='right'), 0, N_EXPERTS - 1)
    xb = hf[tok_buf].reshape(n_blocks, MOE_BLOCK, D)

    def expert_block(args):
        xi, e = args
        hc = xi @ w1[e] + b1[e]
        g, u = hc[:, :D_EXPERT], hc[:, D_EXPERT:]
        g = jnp.minimum(g, SWIGLU_LIMIT)
        u = jnp.clip(u, -SWIGLU_LIMIT, SWIGLU_LIMIT)
        hm = (u + 1.0) * (g * jax.nn.sigmoid(SWIGLU_ALPHA * g))
        return hm @ w2[e] + b2[e]

    yb = lax.map(expert_block, (xb, block_e)).reshape(P, D)
    y = jax.ops.segment_sum(yb.astype(jnp.float32) * gate_buf[:, None], tok_buf, num_segments=T)
    return y.astype(h.dtype).reshape(B, S, D)


def setup_inputs(seed: int = 0) -> dict:
    key = jax.random.key(seed)
    ks = jax.random.split(key, 24)
    f32 = jnp.float32
    L, D = DEPTH, D_MODEL

    def nrm(k, shape, fan_in, mult=1.0):
        return jax.random.normal(k, shape, f32) * (mult * fan_in ** -0.5)

    return {
        "x": jax.random.normal(ks[0], (BATCH, SEQ, D), f32),
        "c": jax.random.normal(ks[1], (BATCH, D), f32),
        "w_ada": nrm(ks[2], (L, D, N_MOD * D), D, 0.5),
        "b_ada": 0.02 * jax.random.normal(ks[3], (L, N_MOD * D), f32),
        "norm1_g": 1.0 + 0.05 * jax.random.normal(ks[4], (L, D), f32),
        "w_in": nrm(ks[5], (L, D, IN_COLS), D),
        "b_forget": jax.random.uniform(ks[6], (L, N_HEADS), f32, 1.0, 4.0),
        "conv_w": nrm(ks[7], (L, CONV_KERNEL, CONV_WIDTH), CONV_KERNEL),
        "conv_b": 0.02 * jax.random.normal(ks[8], (L, CONV_WIDTH), f32),
        "conv_ln_g": 1.0 + 0.05 * jax.random.normal(ks[9], (L, CONV_WIDTH), f32),
        "conv_ln_b": 0.02 * jax.random.normal(ks[10], (L, CONV_WIDTH), f32),
        "w_conv_out": nrm(ks[11], (L, CONV_WIDTH, D), CONV_WIDTH),
        "w_attn_out": nrm(ks[12], (L, ATTN_WIDTH, D), ATTN_WIDTH),
        "w_out": nrm(ks[13], (L, D, D), D),
        "norm2_g": 1.0 + 0.05 * jax.random.normal(ks[14], (L, D), f32),
        "w_router": nrm(ks[15], (L, D, N_EXPERTS), D),
        "b_router": 0.01 * jax.random.normal(ks[16], (L, N_EXPERTS), f32),
        "w_exp_in": nrm(ks[17], (L, N_EXPERTS, D, 2 * D_EXPERT), D),
        "b_exp_in": 0.02 * jax.random.normal(ks[18], (L, N_EXPERTS, 2 * D_EXPERT), f32),
        "w_exp_out": nrm(ks[19], (L, N_EXPERTS, D_EXPERT, D), D_EXPERT),
        "b_exp_out": 0.02 * jax.random.normal(ks[20], (L, N_EXPERTS, D), f32),
        "final_g": 1.0 + 0.05 * jax.random.normal(ks[21], (D,), f32),
    }


def reference(x, c, w_ada, b_ada, norm1_g, w_in, b_forget, conv_w, conv_b, conv_ln_g, conv_ln_b,
              w_conv_out, w_attn_out, w_out, norm2_g, w_router, b_router, w_exp_in, b_exp_in,
              w_exp_out, b_exp_out, final_g):
    B, S, D = x.shape
    offs = np.cumsum(COL_SIZES)[:-1].tolist()
    for l in range(DEPTH):
        mod = (jax.nn.silu(c) @ w_ada[l] + b_ada[l]).reshape(B, N_MOD, D)
        sh1, sc1, g1, sh2, sc2, g2 = (mod[:, i, None, :] for i in range(N_MOD))

        h = rms_norm(x, norm1_g[l]) * (1.0 + sc1) + sh1
        z = h @ w_in[l]
        u_val, u_gate, q, k, v, f_logit, gate_c, gate_a = jnp.split(z, offs, axis=-1)
        conv_out = conv_module(u_val, u_gate, conv_w[l], conv_b[l], conv_ln_g[l], conv_ln_b[l], w_conv_out[l])
        attn = forgetting_attention(q.reshape(B, S, N_HEADS, HEAD_DIM),
                                    k.reshape(B, S, N_HEADS, HEAD_DIM),
                                    v.reshape(B, S, N_HEADS, HEAD_DIM),
                                    f_logit + b_forget[l])
        attn_out = attn @ w_attn_out[l]
        mixed = jax.nn.sigmoid(gate_c) * conv_out + jax.nn.sigmoid(gate_a) * attn_out
        x = x + g1 * (mixed @ w_out[l])

        h2 = rms_norm(x, norm2_g[l]) * (1.0 + sc2) + sh2
        x = x + g2 * moe_ffn(h2, w_router[l], b_router[l], w_exp_in[l], b_exp_in[l], w_exp_out[l], b_exp_out[l])
    return rms_norm(x, final_g)
```

```cpp
#include <hip/hip_runtime.h>
#include <hip/hip_bf16.h>
#include <cstdio>
#include <cstdint>
#include <cmath>

namespace pg8 {
#define PG8_LAS __attribute__((address_space(3)))
typedef unsigned short bf16_t;
typedef short bf16x8 __attribute__((ext_vector_type(8)));
typedef float f32x4 __attribute__((ext_vector_type(4)));
typedef unsigned u32x4 __attribute__((ext_vector_type(4)));
typedef unsigned u32x2 __attribute__((ext_vector_type(2)));
typedef int v8i __attribute__((ext_vector_type(8)));
constexpr int BM = 256, BK = 64, HALF = 128, HTB = HALF * BK * 2  , STAGE_BYTES = 8 * HTB, NXCD = 8, WGM = 8;

__host__ __device__ __forceinline__ int lds_byte(int r, int c) { const int st = (r >> 4) * 2 + (c >> 5), rr = r & 15, cc = c & 31, ob = rr * 64 + cc * 2; return st * 1024 + (ob ^ (((ob >> 9) & 1) << 5)); }
__host__ __device__ __forceinline__ void stage_rc(int b, int& R, int& C) { const int st = b / 1024, sb = b % 1024, swz = sb ^ (((sb >> 9) & 1) << 5); R = (st >> 1) * 16 + swz / 64; C = (st & 1) * 32 + (swz % 64) / 2; }
__host__ __device__ __forceinline__ int perm32(int rho) { const int n = rho >> 4, i = rho & 15; return 8 * (i >> 2) + 4 * n + (i & 3); }

struct Unit { int pm, pn, aux, li; const char* A; const char* B; };

__device__ __forceinline__ void tile_of(int L, int nM, int nN, int& pm, int& pn) {
    const int nwg = nM * nN; int wgid = L; { const int q = nwg / NXCD, r = nwg % NXCD, xcd = wgid % NXCD, off = wgid / NXCD; wgid = (xcd < r ? xcd * (q + 1) : r * (q + 1) + (xcd - r) * q) + off; }
    const int nig = WGM * nN, gid = wgid / nig, fm = gid * WGM, gsz = (nM - fm) < WGM ? (nM - fm) : WGM;
    pm = fm + ((wgid % nig) % gsz); pn = (wgid % nig) / gsz;
}
struct DenseSched {
    const char* A; const char* Bt; int K, nM, nN, nwg, G, c;
    __device__ __forceinline__ void init(const void* A_, const void* Bt_, int M, int N, int K_, int G_, int c_) { A = (const char*)A_; Bt = (const char*)Bt_; K = K_; nM = M / BM; nN = N / BM; nwg = nM * nN; G = G_; c = c_; }
    __device__ __forceinline__ bool next(int i, Unit& u) const {
        const long L = (long)i * G + c; if (L >= nwg) return false;
        tile_of((int)L, nM, nN, u.pm, u.pn); u.aux = 0; u.li = i; u.A = A + (size_t)u.pm * BM * K * 2; u.B = Bt + (size_t)u.pn * BM * K * 2; return true;
    }
    __device__ __forceinline__ void aoff(const Unit&, const int (&R)[2], const int (&Cb)[2], unsigned (&o)[2][2]) const {
#pragma unroll
        for (int h = 0; h < 2; ++h)
#pragma unroll
            for (int i = 0; i < 2; ++i) o[h][i] = (unsigned)((h * HALF + R[i]) * K * 2 + Cb[i]);
    }
};
struct PairSched {
    const char *A0, *B0, *A1, *B1; int K, nM, nN, nwg, G, c;
    __device__ __forceinline__ bool next(int i, Unit& u) const {
        const long L = (long)(i >> 1) * G + c; if (L >= nwg) return false;
        tile_of((int)L, nM, nN, u.pm, u.pn); u.aux = i & 1; u.li = i;
        u.A = ((i & 1) ? A1 : A0) + (size_t)u.pm * BM * K * 2; u.B = ((i & 1) ? B1 : B0) + (size_t)u.pn * BM * K * 2; return true;
    }
    __device__ __forceinline__ void aoff(const Unit&, const int (&R)[2], const int (&Cb)[2], unsigned (&o)[2][2]) const {
#pragma unroll
        for (int h = 0; h < 2; ++h)
#pragma unroll
            for (int i = 0; i < 2; ++i) o[h][i] = (unsigned)((h * HALF + R[i]) * K * 2 + Cb[i]);
    }
};
template <int NT_N, bool GATHER> struct MoeSched {
    const char* A; const char* W; const int* tile_e; int K, U, PER, x, r, Wd; size_t wstride_e; PG8_LAS const int* rows;
    __device__ __forceinline__ bool next(int i, Unit& u) const {
        const int q = i * Wd + r; if (q >= PER) return false; const int g = x * PER + q; if (g >= U) return false;
        const int tile = g / NT_N, pn = g % NT_N; const int e = tile_e[tile];
        u.pm = tile; u.pn = pn; u.aux = e; u.li = i; u.A = GATHER ? A : A + (size_t)tile * BM * K * 2; u.B = W + (size_t)e * wstride_e + (size_t)pn * BM * K * 2; return true;
    }
    __device__ __forceinline__ void aoff(const Unit& u, const int (&R)[2], const int (&Cb)[2], unsigned (&o)[2][2]) const {
#pragma unroll
        for (int h = 0; h < 2; ++h)
#pragma unroll
            for (int i = 0; i < 2; ++i) { const int rr = h * HALF + R[i]; o[h][i] = GATHER ? (unsigned)(rows[u.li * 256 + rr] * K * 2 + Cb[i]) : (unsigned)(rr * K * 2 + Cb[i]); }
    }
};

typedef float f32x2_c __attribute__((ext_vector_type(2))); typedef __bf16 bf16x2_c __attribute__((ext_vector_type(2)));
__device__ __forceinline__ unsigned cvt_pk_bf16(float lo, float hi) { const f32x2_c v = {lo, hi}; const bf16x2_c b = __builtin_convertvector(v, bf16x2_c); return __builtin_bit_cast(unsigned, b); }
__device__ __forceinline__ float bf_lo(unsigned u) { return __builtin_bit_cast(float, u << 16); }
__device__ __forceinline__ float bf_hi(unsigned u) { return __builtin_bit_cast(float, u & 0xffff0000u); }
__device__ __forceinline__ float sigm(float x) { return __builtin_amdgcn_rcpf(1.f + __builtin_amdgcn_exp2f(-1.4426950408889634f * x)); }

typedef f32x4 Acc[2][2][4][2];

struct EpiIn {
    static constexpr bool PERM = true;
    struct Pre { int none; };
    __device__ __forceinline__ Pre pre(const Unit&, int, int) const { return Pre{0}; }
    bf16_t *AGLU, *QKV, *SG; size_t qkv_stride, sg_stride; float qscale; unsigned* NORM; int rows_per_batch; float ascale;
    __device__ __forceinline__ void operator()(const Acc& acc, const Unit& u, const Pre&, int wr, int wc, int fr, int fq) const {
        const int row0 = u.pm * BM + wr * 64 + fr; const int pn = u.pn;
        if (pn < 4) {
#pragma unroll
            for (int ai = 0; ai < 2; ++ai)
#pragma unroll
                for (int m = 0; m < 4; ++m) { bf16_t* rowp = AGLU + (size_t)(row0 + ai * HALF + m * 16) * 512 + pn * 128 + wc * 32 + 8 * fq;
                    const f32x4 v0 = acc[ai][0][m][0] * ascale, v1 = acc[ai][0][m][1] * ascale, g0 = acc[ai][1][m][0] * ascale, g1 = acc[ai][1][m][1] * ascale;
                    u32x4 w; w.x = cvt_pk_bf16(v0[0] * sigm(g0[0]), v0[1] * sigm(g0[1])); w.y = cvt_pk_bf16(v0[2] * sigm(g0[2]), v0[3] * sigm(g0[3]));
                    w.z = cvt_pk_bf16(v1[0] * sigm(g1[0]), v1[1] * sigm(g1[1])); w.w = cvt_pk_bf16(v1[2] * sigm(g1[2]), v1[3] * sigm(g1[3]));
                    *(u32x4*)rowp = w; }
        } else if (pn < 10) {
            const int t = (pn - 4) >> 1; bf16_t* base = QKV + (size_t)t * qkv_stride; const float sc = ((t == 0) ? qscale : 1.f) * ascale;
            const int col0 = ((pn - 4) & 1) * 256 + wc * 32 + 8 * fq; float nmx[2] = {0.f, 0.f};
#pragma unroll
            for (int ai = 0; ai < 2; ++ai)
#pragma unroll
                for (int m = 0; m < 4; ++m) { bf16_t* rowp = base + (size_t)(row0 + ai * HALF + m * 16) * 512 + col0;
#pragma unroll
                    for (int bj = 0; bj < 2; ++bj) { const f32x4 v0 = acc[ai][bj][m][0] * sc, v1 = acc[ai][bj][m][1] * sc;
                        if (t < 2) { float ssq = (v0[0] * v0[0] + v0[1] * v0[1]) + (v0[2] * v0[2] + v0[3] * v0[3]) + (v1[0] * v1[0] + v1[1] * v1[1]) + (v1[2] * v1[2] + v1[3] * v1[3]);
                            ssq += __shfl_xor(ssq, 16); ssq += __shfl_xor(ssq, 32); nmx[bj] = fmaxf(nmx[bj], ssq); }
                        u32x4 w; w.x = cvt_pk_bf16(v0[0], v0[1]); w.y = cvt_pk_bf16(v0[2], v0[3]); w.z = cvt_pk_bf16(v1[0], v1[1]); w.w = cvt_pk_bf16(v1[2], v1[3]);
                        *(u32x4*)(rowp + bj * HALF) = w; } }
            if (t < 2) {
#pragma unroll
                for (int bj = 0; bj < 2; ++bj) { float r = nmx[bj];
#pragma unroll
                    for (int o = 1; o < 16; o <<= 1) r = fmaxf(r, __shfl_xor(r, o));
                    const int head = ((pn - 4) & 1) * 4 + bj * 2 + (wc >> 1), bb = (u.pm * BM) / rows_per_batch;
                    if ((threadIdx.x & 63) == 0) atomicMax(NORM + (bb * 8 + head) * 2 + t, __builtin_bit_cast(unsigned, r)); } }
        } else {
            const int t = (pn - 10) >> 2; bf16_t* base = SG + (size_t)t * sg_stride; const int col0 = ((pn - 10) & 3) * 256 + wc * 32 + 8 * fq;
#pragma unroll
            for (int ai = 0; ai < 2; ++ai)
#pragma unroll
                for (int m = 0; m < 4; ++m) { bf16_t* rowp = base + (size_t)(row0 + ai * HALF + m * 16) * 1024 + col0;
#pragma unroll
                    for (int bj = 0; bj < 2; ++bj) { const f32x4 v0 = acc[ai][bj][m][0] * ascale, v1 = acc[ai][bj][m][1] * ascale;
                        u32x4 w; w.x = cvt_pk_bf16(sigm(v0[0]), sigm(v0[1])); w.y = cvt_pk_bf16(sigm(v0[2]), sigm(v0[3])); w.z = cvt_pk_bf16(sigm(v1[0]), sigm(v1[1])); w.w = cvt_pk_bf16(sigm(v1[2]), sigm(v1[3]));
                        *(u32x4*)(rowp + bj * HALF) = w; } }
        }
    }
};
struct EpiMix {
    static constexpr bool PERM = true;
    const bf16_t* SG; size_t sg_stride; bf16_t* MIX;
    __device__ __forceinline__ void operator()(const Acc& acc, const Unit& u, int wr, int wc, int fr, int fq) const {
        const int row0 = u.pm * BM + wr * 64 + fr, col0 = u.pn * BM + wc * 32 + 8 * fq; const bf16_t* G = SG + (size_t)u.aux * sg_stride;
#pragma unroll
        for (int ai = 0; ai < 2; ++ai)
#pragma unroll
            for (int m = 0; m < 4; ++m) { const size_t ro = (size_t)(row0 + ai * HALF + m * 16) * 1024 + col0;
#pragma unroll
                for (int bj = 0; bj < 2; ++bj) { const u32x4 g = *(const u32x4*)(G + ro + bj * HALF); const f32x4 v0 = acc[ai][bj][m][0], v1 = acc[ai][bj][m][1];
                    float o0 = bf_lo(g.x) * v0[0], o1 = bf_hi(g.x) * v0[1], o2 = bf_lo(g.y) * v0[2], o3 = bf_hi(g.y) * v0[3], o4 = bf_lo(g.z) * v1[0], o5 = bf_hi(g.z) * v1[1], o6 = bf_lo(g.w) * v1[2], o7 = bf_hi(g.w) * v1[3];
                    if (u.aux) { const u32x4 p = *(const u32x4*)(MIX + ro + bj * HALF);
                        o0 += bf_lo(p.x); o1 += bf_hi(p.x); o2 += bf_lo(p.y); o3 += bf_hi(p.y); o4 += bf_lo(p.z); o5 += bf_hi(p.z); o6 += bf_lo(p.w); o7 += bf_hi(p.w); }
                    u32x4 w; w.x = cvt_pk_bf16(o0, o1); w.y = cvt_pk_bf16(o2, o3); w.z = cvt_pk_bf16(o4, o5); w.w = cvt_pk_bf16(o6, o7);
                    *(u32x4*)(MIX + ro + bj * HALF) = w; } }
    }
};
struct EpiRes {
    static constexpr bool PERM = true;
    const float* X; const float* G1; bf16_t* X1; int rows_per_batch; int gstride;
    __device__ __forceinline__ void operator()(const Acc& acc, const Unit& u, int wr, int wc, int fr, int fq) const {
        const int row0 = u.pm * BM + wr * 64 + fr, col0 = u.pn * BM + wc * 32 + 8 * fq;
        const float* g = G1 + (size_t)((u.pm * BM) / rows_per_batch) * gstride + col0;
        f32x4 gv[2][2];
#pragma unroll
        for (int bj = 0; bj < 2; ++bj)
#pragma unroll
            for (int n = 0; n < 2; ++n) gv[bj][n] = *(const f32x4*)(g + bj * HALF + 4 * n);
#pragma unroll
        for (int ai = 0; ai < 2; ++ai)
#pragma unroll
            for (int m = 0; m < 4; ++m) { const size_t o = (size_t)(row0 + ai * HALF + m * 16) * 1024 + col0;
#pragma unroll
                for (int bj = 0; bj < 2; ++bj) { const f32x4 x0 = *(const f32x4*)(X + o + bj * HALF), x1 = *(const f32x4*)(X + o + bj * HALF + 4);
                    const f32x4 v0 = x0 + gv[bj][0] * acc[ai][bj][m][0], v1 = x1 + gv[bj][1] * acc[ai][bj][m][1];
                    u32x4 w; w.x = cvt_pk_bf16(v0[0], v0[1]); w.y = cvt_pk_bf16(v0[2], v0[3]); w.z = cvt_pk_bf16(v1[0], v1[1]); w.w = cvt_pk_bf16(v1[2], v1[3]);
                    *(u32x4*)(X1 + o + bj * HALF) = w; } }
    }
};
__device__ __forceinline__ unsigned pk4_fp8(float a, float b, float c, float d) { int w = 0; w = __builtin_amdgcn_cvt_pk_fp8_f32(a, b, w, false); w = __builtin_amdgcn_cvt_pk_fp8_f32(c, d, w, true); return (unsigned)w; }
typedef float f32x2 __attribute__((ext_vector_type(2)));
__device__ __forceinline__ f32x2 swiglu2(f32x2 ga, f32x2 ua, f32x2 bg, f32x2 bu) {
    f32x2 g = ga * 0.03125f + bg, u = ua * 0.03125f + bu;
    g.x = fminf(g.x, 7.f); g.y = fminf(g.y, 7.f); u.x = fminf(fmaxf(u.x, -7.f), 7.f); u.y = fminf(fmaxf(u.y, -7.f), 7.f);
    const f32x2 t = g * (-1.702f * 1.4426950408889634f);
    f32x2 e; e.x = __builtin_amdgcn_exp2f(t.x); e.y = __builtin_amdgcn_exp2f(t.y);
    const f32x2 d = e + 1.f;
    f32x2 r; r.x = __builtin_amdgcn_rcpf(d.x); r.y = __builtin_amdgcn_rcpf(d.y);
    const f32x2 s = g * r;
    return u * s + s;
}
struct EpiSwiglu8 {
    static constexpr bool PERM = true;
    const float* B1; unsigned char* HM8;
    struct Pre { f32x4 bg0, bg1, bu0, bu1; };
    __device__ __forceinline__ Pre pre(const Unit& u, int wc, int fq) const { const int colh = u.pn * 128 + wc * 32 + 8 * fq; const float* b1 = B1 + (size_t)u.aux * 2048;
        Pre p; p.bg0 = *(const f32x4*)(b1 + colh); p.bg1 = *(const f32x4*)(b1 + colh + 4); p.bu0 = *(const f32x4*)(b1 + 1024 + colh); p.bu1 = *(const f32x4*)(b1 + 1024 + colh + 4); return p; }
    __device__ __forceinline__ void operator()(const Acc& acc, const Unit& u, const Pre& P, int wr, int wc, int fr, int fq) const {
        const int row0 = u.pm * BM + wr * 64 + fr, colh = u.pn * 128 + wc * 32 + 8 * fq;
        const f32x4 bg0 = P.bg0, bg1 = P.bg1, bu0 = P.bu0, bu1 = P.bu1;
#pragma unroll
        for (int ai = 0; ai < 2; ++ai)
#pragma unroll
            for (int m = 0; m < 4; ++m) { unsigned char* rowp = HM8 + (size_t)(row0 + ai * HALF + m * 16) * 1024 + colh;
                const f32x4 ga0 = acc[ai][0][m][0], ga1 = acc[ai][0][m][1], ua0 = acc[ai][1][m][0], ua1 = acc[ai][1][m][1];
                const f32x2 o0 = swiglu2(ga0.xy, ua0.xy, bg0.xy, bu0.xy), o1 = swiglu2(ga0.zw, ua0.zw, bg0.zw, bu0.zw), o2 = swiglu2(ga1.xy, ua1.xy, bg1.xy, bu1.xy), o3 = swiglu2(ga1.zw, ua1.zw, bg1.zw, bu1.zw);
                const float o[8] = {o0.x, o0.y, o1.x, o1.y, o2.x, o2.y, o3.x, o3.y};
                u32x2 w; w.x = pk4_fp8(o[0], o[1], o[2], o[3]); w.y = pk4_fp8(o[4], o[5], o[6], o[7]);
                *(u32x2*)rowp = w; }
    }
};
struct EpiYb8 {
    static constexpr bool PERM = true;
    const float* B2; bf16_t* YB;
    struct Pre { f32x4 bv[2][2]; };
    __device__ __forceinline__ Pre pre(const Unit& u, int wc, int fq) const { const float* b2 = B2 + (size_t)u.aux * 1024 + u.pn * BM + wc * 32 + 8 * fq; Pre p;
#pragma unroll
        for (int bj = 0; bj < 2; ++bj)
#pragma unroll
            for (int n = 0; n < 2; ++n) p.bv[bj][n] = *(const f32x4*)(b2 + bj * HALF + 4 * n);
        return p; }
    __device__ __forceinline__ void operator()(const Acc& acc, const Unit& u, const Pre& P, int wr, int wc, int fr, int fq) const {
        const int row0 = u.pm * BM + wr * 64 + fr, col0 = u.pn * BM + wc * 32 + 8 * fq;
#pragma unroll
        for (int ai = 0; ai < 2; ++ai)
#pragma unroll
            for (int m = 0; m < 4; ++m) { bf16_t* rowp = YB + (size_t)(row0 + ai * HALF + m * 16) * 1024 + col0;
#pragma unroll
                for (int bj = 0; bj < 2; ++bj) { const f32x4 v0 = acc[ai][bj][m][0] * 0.03125f + P.bv[bj][0], v1 = acc[ai][bj][m][1] * 0.03125f + P.bv[bj][1];
                    u32x4 w; w.x = cvt_pk_bf16(v0[0], v0[1]); w.y = cvt_pk_bf16(v0[2], v0[3]); w.z = cvt_pk_bf16(v1[0], v1[1]); w.w = cvt_pk_bf16(v1[2], v1[3]);
                    *(u32x4*)(rowp + bj * HALF) = w; } }
    }
};


template <class Epi, class Sched, bool ALIGN_EPI>
__device__ __forceinline__ void gemm_phase(PG8_LAS unsigned char* lds, const int K, const Sched& S, const Epi& E) {
    const int tid = threadIdx.x, wid = __builtin_amdgcn_readfirstlane(tid >> 6), lane = tid & 63, wr = wid >> 2, wc = wid & 3, fr = lane & 15, fq = lane >> 4;
    const int nt = K / BK;
    int R[2], Cb[2]; unsigned voffB[2];
#pragma unroll
    for (int i = 0; i < 2; ++i) { int R_, C_; stage_rc(tid * 16 + i * 8192, R_, C_); const int Rb = Epi::PERM ? ((R_ & ~31) + perm32(R_ & 31)) : R_;
        R[i] = R_; Cb[i] = C_ * 2; voffB[i] = (unsigned)(Rb * K + C_) * 2u; }
    const size_t kstep = (size_t)(BK * 2);
    const size_t hstep = (size_t)HALF * K * 2;
    const unsigned ldsw = (unsigned)wid * 1024u;
    const int aoffl = lds_byte(wr * 64 + fr, fq * 8), boffl = lds_byte(wc * 32 + fr, fq * 8);
#define PG8_SA(b, h) (((b) * 2 + (h)) * HTB)
#define PG8_SB(b, h) ((4 + (b) * 2 + (h)) * HTB)
#define PG8_STAGE_B(bufoff, gbase) do { _Pragma("unroll") for (int _i = 0; _i < 2; ++_i) \
        __builtin_amdgcn_global_load_lds((const unsigned*)((const char*)(gbase) + voffB[_i]), (PG8_LAS unsigned*)(lds + (bufoff) + ldsw + _i * 8192), 16, 0, 0); } while (0)
#define PG8_STAGE_A(bufoff, gbase, o0, o1) do { \
        __builtin_amdgcn_global_load_lds((const unsigned*)((const char*)(gbase) + (o0)), (PG8_LAS unsigned*)(lds + (bufoff) + ldsw), 16, 0, 0); \
        __builtin_amdgcn_global_load_lds((const unsigned*)((const char*)(gbase) + (o1)), (PG8_LAS unsigned*)(lds + (bufoff) + ldsw + 8192), 16, 0, 0); } while (0)
#define PG8_LDA(dst, b, h) do { _Pragma("unroll") for (int m = 0; m < 4; ++m) _Pragma("unroll") for (int k = 0; k < 2; ++k) dst[m][k] = *(const PG8_LAS bf16x8*)(lds + PG8_SA(b, h) + aoffl + m * 2048 + k * 1024); } while (0)
#define PG8_LDB(dst, b, h) do { _Pragma("unroll") for (int n = 0; n < 2; ++n) _Pragma("unroll") for (int k = 0; k < 2; ++k) dst[n][k] = *(const PG8_LAS bf16x8*)(lds + PG8_SB(b, h) + boffl + n * 2048 + k * 1024); } while (0)
#define PG8_MMA(ai, bj, At, Bt) do { __builtin_amdgcn_s_setprio(1); _Pragma("unroll") for (int m = 0; m < 4; ++m) _Pragma("unroll") for (int n = 0; n < 2; ++n) _Pragma("unroll") for (int k = 0; k < 2; ++k) \
        acc[ai][bj][m][n] = __builtin_amdgcn_mfma_f32_16x16x32_bf16(Bt[n][k], At[m][k], acc[ai][bj][m][n], 0, 0, 0); __builtin_amdgcn_s_setprio(0); } while (0)
#define PG8_WAIT_V(n) asm volatile("s_waitcnt vmcnt(" #n ")" ::: "memory")
#define PG8_WAIT_L(n) asm volatile("s_waitcnt lgkmcnt(" #n ")" ::: "memory")
#define PG8_BAR __builtin_amdgcn_s_barrier()
#define PG8_SCHED __builtin_amdgcn_sched_barrier(0)
    Unit cur, nxt; int ui = 0;
    if (!S.next(0, cur)) return;
    Acc acc;
#pragma unroll
    for (int a = 0; a < 2; ++a)
#pragma unroll
        for (int b = 0; b < 2; ++b)
#pragma unroll
            for (int m = 0; m < 4; ++m)
#pragma unroll
                for (int n = 0; n < 2; ++n) acc[a][b][m][n] = (f32x4){0.f, 0.f, 0.f, 0.f};
    bf16x8 At[4][2], B0[2][2], B1[2][2];
    unsigned oa[2][2], na[2][2];
    S.aoff(cur, R, Cb, oa);
    const char* cA = cur.A; const char* cB = cur.B;
    PG8_STAGE_B(PG8_SB(0, 0), cB); PG8_STAGE_B(PG8_SB(0, 1), cB + hstep); PG8_STAGE_A(PG8_SA(0, 0), cA, oa[0][0], oa[0][1]); PG8_STAGE_A(PG8_SA(0, 1), cA, oa[1][0], oa[1][1]);
    if (wr == 1) PG8_BAR;
    PG8_WAIT_V(2); PG8_BAR;
    PG8_STAGE_B(PG8_SB(1, 0), cB + kstep); PG8_STAGE_A(PG8_SA(1, 0), cA + kstep, oa[0][0], oa[0][1]); PG8_STAGE_B(PG8_SB(1, 1), cB + hstep + kstep);
    PG8_WAIT_V(6); PG8_BAR;
    for (;;) {
        const bool has_next = S.next(ui + 1, nxt);
        if (has_next) S.aoff(nxt, R, Cb, na);
        else {
#pragma unroll
            for (int h = 0; h < 2; ++h)
#pragma unroll
                for (int i = 0; i < 2; ++i) na[h][i] = oa[h][i];
        }
        const char* nA = has_next ? nxt.A : cA; const char* nB = has_next ? nxt.B : cB;
        for (int t = 0; t < nt; t += 2) {
            const bool last = (t == nt - 2);
            const char* a1 = cA + (size_t)(t + 1) * kstep;
            const char* a2 = last ? nA : cA + (size_t)(t + 2) * kstep; const char* b2 = last ? nB : cB + (size_t)(t + 2) * kstep;
            const char* a3 = a2 + kstep; const char* b3 = b2 + kstep;
            const unsigned p00 = last ? na[0][0] : oa[0][0], p01 = last ? na[0][1] : oa[0][1], p10 = last ? na[1][0] : oa[1][0], p11 = last ? na[1][1] : oa[1][1];
            PG8_LDB(B0, 0, 0); PG8_LDB(B1, 0, 1); PG8_SCHED; PG8_LDA(At, 0, 0); PG8_STAGE_A(PG8_SA(1, 1), a1, oa[1][0], oa[1][1]);
            PG8_WAIT_V(8); PG8_WAIT_L(0); PG8_BAR; PG8_MMA(0, 0, At, B0); PG8_MMA(0, 1, At, B1); PG8_BAR; PG8_SCHED;
            PG8_LDA(At, 0, 1); PG8_STAGE_B(PG8_SB(0, 0), b2); PG8_STAGE_B(PG8_SB(0, 1), b2 + hstep); PG8_STAGE_A(PG8_SA(0, 0), a2, p00, p01);
            PG8_WAIT_V(8); PG8_WAIT_L(0); PG8_BAR; PG8_MMA(1, 0, At, B0); PG8_MMA(1, 1, At, B1); PG8_BAR; PG8_SCHED;
            PG8_LDB(B0, 1, 0); PG8_LDB(B1, 1, 1); PG8_SCHED; PG8_LDA(At, 1, 0); PG8_STAGE_A(PG8_SA(0, 1), a2, p10, p11);
            PG8_WAIT_V(8); PG8_WAIT_L(0); PG8_BAR; PG8_MMA(0, 0, At, B0); PG8_MMA(0, 1, At, B1); PG8_BAR; PG8_SCHED;
            PG8_LDA(At, 1, 1); PG8_STAGE_B(PG8_SB(1, 0), b3); PG8_STAGE_B(PG8_SB(1, 1), b3 + hstep); PG8_STAGE_A(PG8_SA(1, 0), a3, p00, p01);
            PG8_WAIT_V(8); PG8_WAIT_L(0); PG8_BAR; PG8_MMA(1, 0, At, B0); PG8_MMA(1, 1, At, B1); PG8_BAR; PG8_SCHED;
        }
        if constexpr (ALIGN_EPI) { if (wr == 0) PG8_BAR; }
        E(acc, cur, wr, wc, fr, fq);
        if (!has_next) break;
#pragma unroll
        for (int a = 0; a < 2; ++a)
#pragma unroll
            for (int b = 0; b < 2; ++b)
#pragma unroll
                for (int m = 0; m < 4; ++m)
#pragma unroll
                    for (int n = 0; n < 2; ++n) acc[a][b][m][n] = (f32x4){0.f, 0.f, 0.f, 0.f};
        cur = nxt; cA = nA; cB = nB; ++ui;
#pragma unroll
        for (int h = 0; h < 2; ++h)
#pragma unroll
            for (int i = 0; i < 2; ++i) oa[h][i] = na[h][i];
        if constexpr (ALIGN_EPI) { if (wr == 1) PG8_BAR; }
    }
    PG8_WAIT_V(0);
    if constexpr (!ALIGN_EPI) { if (wr == 0) PG8_BAR; }
    PG8_BAR;
#undef PG8_SA
#undef PG8_SB
#undef PG8_STAGE_A
#undef PG8_STAGE_B
#undef PG8_LDA
#undef PG8_LDB
#undef PG8_MMA
#undef PG8_WAIT_V
#undef PG8_WAIT_L
#undef PG8_BAR
#undef PG8_SCHED
}
template <class Epi, class Sched, bool ALIGN_EPI>
__device__ __forceinline__ void gemm_phase8(PG8_LAS unsigned char* lds, const int K, const Sched& S, const Epi& E) {
    const int tid = threadIdx.x, wid = __builtin_amdgcn_readfirstlane(tid >> 6), lane = tid & 63, wr = wid >> 2, wc = wid & 3, fr = lane & 15, fq = lane >> 4;
    const int nt = K / BK;
    int R[2], Cb[2]; unsigned voffB[2];
#pragma unroll
    for (int i = 0; i < 2; ++i) { int R_, C_; stage_rc(tid * 16 + i * 8192, R_, C_); const int Rb = Epi::PERM ? ((R_ & ~31) + perm32(R_ & 31)) : R_;
        R[i] = R_; Cb[i] = C_ * 2; voffB[i] = (unsigned)(Rb * K + C_) * 2u; }
    const size_t kstep = (size_t)(BK * 2);
    const size_t hstep = (size_t)HALF * K * 2;
    const unsigned ldsw = (unsigned)wid * 1024u;
    const int aoffl = lds_byte(wr * 64 + fr, fq * 16), boffl = lds_byte(wc * 32 + fr, fq * 16);
#define PG8_SA(b, h) (((b) * 2 + (h)) * HTB)
#define PG8_SB(b, h) ((4 + (b) * 2 + (h)) * HTB)
#define PG8_STAGE_B(bufoff, gbase) do { _Pragma("unroll") for (int _i = 0; _i < 2; ++_i) \
        __builtin_amdgcn_global_load_lds((const unsigned*)((const char*)(gbase) + voffB[_i]), (PG8_LAS unsigned*)(lds + (bufoff) + ldsw + _i * 8192), 16, 0, 0); } while (0)
#define PG8_STAGE_A(bufoff, gbase, o0, o1) do { \
        __builtin_amdgcn_global_load_lds((const unsigned*)((const char*)(gbase) + (o0)), (PG8_LAS unsigned*)(lds + (bufoff) + ldsw), 16, 0, 0); \
        __builtin_amdgcn_global_load_lds((const unsigned*)((const char*)(gbase) + (o1)), (PG8_LAS unsigned*)(lds + (bufoff) + ldsw + 8192), 16, 0, 0); } while (0)
#define PG8_LD32(p) __builtin_bit_cast(v8i, __builtin_shufflevector(*(const PG8_LAS bf16x8*)(p), *(const PG8_LAS bf16x8*)((p) + 16), 0, 1, 2, 3, 4, 5, 6, 7, 8, 9, 10, 11, 12, 13, 14, 15))
#define PG8_LDA(dst, b, h) do { _Pragma("unroll") for (int m = 0; m < 4; ++m) dst[m] = PG8_LD32(lds + PG8_SA(b, h) + aoffl + m * 2048); } while (0)
#define PG8_LDB(dst, b, h) do { _Pragma("unroll") for (int n = 0; n < 2; ++n) dst[n] = PG8_LD32(lds + PG8_SB(b, h) + boffl + n * 2048); } while (0)
#define PG8_MMA(ai, bj, At, Bt) do { __builtin_amdgcn_s_setprio(1); _Pragma("unroll") for (int m = 0; m < 4; ++m) _Pragma("unroll") for (int n = 0; n < 2; ++n) \
        asm volatile("v_mfma_f32_16x16x128_f8f6f4 %0, %1, %2, %0" : "+v"(acc[ai][bj][m][n]) : "v"(Bt[n]), "v"(At[m])); __builtin_amdgcn_s_setprio(0); } while (0)
#define PG8_WAIT_V(n) asm volatile("s_waitcnt vmcnt(" #n ")" ::: "memory")
#define PG8_WAIT_L(n) asm volatile("s_waitcnt lgkmcnt(" #n ")" ::: "memory")
#define PG8_BAR __builtin_amdgcn_s_barrier()
#define PG8_SCHED __builtin_amdgcn_sched_barrier(0)
    Unit cur, nxt; int ui = 0;
    if (!S.next(0, cur)) return;
    Acc acc;
#pragma unroll
    for (int a = 0; a < 2; ++a)
#pragma unroll
        for (int b = 0; b < 2; ++b)
#pragma unroll
            for (int m = 0; m < 4; ++m)
#pragma unroll
                for (int n = 0; n < 2; ++n) acc[a][b][m][n] = (f32x4){0.f, 0.f, 0.f, 0.f};
    v8i At[4], B0[2], B1[2];
    unsigned oa[2][2], na[2][2];
    S.aoff(cur, R, Cb, oa);
    typename Epi::Pre pre = E.pre(cur, wc, fq);
    const char* cA = cur.A; const char* cB = cur.B;
    PG8_STAGE_B(PG8_SB(0, 0), cB); PG8_STAGE_B(PG8_SB(0, 1), cB + hstep); PG8_STAGE_A(PG8_SA(0, 0), cA, oa[0][0], oa[0][1]); PG8_STAGE_A(PG8_SA(0, 1), cA, oa[1][0], oa[1][1]);
    if (wr == 1) PG8_BAR;
    PG8_WAIT_V(2); PG8_BAR;
    PG8_STAGE_B(PG8_SB(1, 0), cB + kstep); PG8_STAGE_A(PG8_SA(1, 0), cA + kstep, oa[0][0], oa[0][1]); PG8_STAGE_B(PG8_SB(1, 1), cB + hstep + kstep);
    PG8_WAIT_V(6); PG8_BAR;
    for (;;) {
        const bool has_next = S.next(ui + 1, nxt);
        if (has_next) S.aoff(nxt, R, Cb, na);
        else {
#pragma unroll
            for (int h = 0; h < 2; ++h)
#pragma unroll
                for (int i = 0; i < 2; ++i) na[h][i] = oa[h][i];
        }
        const char* nA = has_next ? nxt.A : cA; const char* nB = has_next ? nxt.B : cB;
#pragma unroll 1
        for (int t = 0; t < nt; t += 2) {
            const bool last = (t == nt - 2);
            const char* a1 = cA + (size_t)(t + 1) * kstep;
            const char* a2 = last ? nA : cA + (size_t)(t + 2) * kstep; const char* b2 = last ? nB : cB + (size_t)(t + 2) * kstep;
            const char* a3 = a2 + kstep; const char* b3 = b2 + kstep;
            const unsigned p00 = last ? na[0][0] : oa[0][0], p01 = last ? na[0][1] : oa[0][1], p10 = last ? na[1][0] : oa[1][0], p11 = last ? na[1][1] : oa[1][1];
            PG8_LDB(B0, 0, 0); PG8_LDB(B1, 0, 1); PG8_SCHED; PG8_LDA(At, 0, 0); PG8_STAGE_A(PG8_SA(1, 1), a1, oa[1][0], oa[1][1]);
            PG8_WAIT_V(8); PG8_WAIT_L(0); PG8_BAR; PG8_MMA(0, 0, At, B0); PG8_MMA(0, 1, At, B1); PG8_BAR; PG8_SCHED;
            PG8_LDA(At, 0, 1); PG8_STAGE_B(PG8_SB(0, 0), b2); PG8_STAGE_B(PG8_SB(0, 1), b2 + hstep); PG8_STAGE_A(PG8_SA(0, 0), a2, p00, p01);
            PG8_WAIT_V(8); PG8_WAIT_L(0); PG8_BAR; PG8_MMA(1, 0, At, B0); PG8_MMA(1, 1, At, B1); PG8_BAR; PG8_SCHED;
            PG8_LDB(B0, 1, 0); PG8_LDB(B1, 1, 1); PG8_SCHED; PG8_LDA(At, 1, 0); PG8_STAGE_A(PG8_SA(0, 1), a2, p10, p11);
            PG8_WAIT_V(8); PG8_WAIT_L(0); PG8_BAR; PG8_MMA(0, 0, At, B0); PG8_MMA(0, 1, At, B1); PG8_BAR; PG8_SCHED;
            PG8_LDA(At, 1, 1); PG8_STAGE_B(PG8_SB(1, 0), b3); PG8_STAGE_B(PG8_SB(1, 1), b3 + hstep); PG8_STAGE_A(PG8_SA(1, 0), a3, p00, p01);
            PG8_WAIT_V(8); PG8_WAIT_L(0); PG8_BAR; PG8_MMA(1, 0, At, B0); PG8_MMA(1, 1, At, B1); PG8_BAR; PG8_SCHED;
        }
        if constexpr (ALIGN_EPI) { if (wr == 0) PG8_BAR; }
        asm volatile("s_nop 15\n\ts_nop 7" ::: "memory");
        E(acc, cur, pre, wr, wc, fr, fq);
        if (!has_next) break;
#pragma unroll
        for (int a = 0; a < 2; ++a)
#pragma unroll
            for (int b = 0; b < 2; ++b)
#pragma unroll
                for (int m = 0; m < 4; ++m)
#pragma unroll
                    for (int n = 0; n < 2; ++n) acc[a][b][m][n] = (f32x4){0.f, 0.f, 0.f, 0.f};
        cur = nxt; cA = nA; cB = nB; ++ui; pre = E.pre(cur, wc, fq);
#pragma unroll
        for (int h = 0; h < 2; ++h)
#pragma unroll
            for (int i = 0; i < 2; ++i) oa[h][i] = na[h][i];
        if constexpr (ALIGN_EPI) { if (wr == 1) PG8_BAR; }
    }
    PG8_WAIT_V(0);
    if constexpr (!ALIGN_EPI) { if (wr == 0) PG8_BAR; }
    PG8_BAR;
#undef PG8_SA
#undef PG8_SB
#undef PG8_STAGE_A
#undef PG8_STAGE_B
#undef PG8_LD32
#undef PG8_LDA
#undef PG8_LDB
#undef PG8_MMA
#undef PG8_WAIT_V
#undef PG8_WAIT_L
#undef PG8_BAR
#undef PG8_SCHED
}
}
namespace attn_body {
using bf16=__hip_bfloat16;
using bf16x8=__attribute__((ext_vector_type(8)))short;
using s16x4=__attribute__((ext_vector_type(4)))short;
using f32x16=__attribute__((ext_vector_type(16)))float;
using u32x4=__attribute__((ext_vector_type(4)))unsigned;
constexpr int BATCH=2,NHEAD=8,SEQ=8192,D=64,DM=NHEAD*D;
constexpr int NW=8,QBLK=32,QB=QBLK*NW,KVBLK=64,NQB=SEQ/QB;
constexpr int ATTN_PITCH=DM, ATTN_UNIT_ROWS=QB;
__device__ __forceinline__ int crow(int r,int hi){return (r&3)+8*(r>>2)+4*hi;}
#define SBAR() __builtin_amdgcn_sched_barrier(0)
__device__ __forceinline__ void cmask(f32x16&p0,f32x16&p1,int jb,int qrel,int hi){
  const float NEG=-INFINITY; int kb=64*jb+4*hi;
  #pragma unroll
  for(int r=0;r<16;++r){int kv=kb+(r&3)+8*(r>>2); if(kv>qrel)p0[r]=NEG; if(kv+32>qrel)p1[r]=NEG;}
}

constexpr int NSLOT=3, SLOTB=8192;
constexpr int LDS_K=0, LDS_V=NSLOT*SLOTB, LDS_WS=2*NSLOT*SLOTB, LDS_OST=LDS_WS+NW*64*4, LDS_KX=LDS_OST+NW*4096, LDS_BYTES=LDS_KX+NSLOT*1024;
constexpr float C2=0.125f*1.4426950408889634f;
__device__ __forceinline__ void glds16(const void*gsrc,unsigned lds_dst){unsigned keep;
  asm volatile("s_mov_b32 %0, m0\n\ts_mov_b32 m0, %2\n\ts_nop 0\n\tglobal_load_lds_dwordx4 %1, off\n\ts_mov_b32 m0, %0":"=&s"(keep):"v"(gsrc),"s"(lds_dst):"memory");}
__device__ __forceinline__ float max3f(float a,float b,float c){float r;asm("v_max3_f32 %0, %1, %2, %3":"=v"(r):"v"(a),"v"(b),"v"(c));return r;}
__device__ __forceinline__ float max2f(float a,float b){float r;asm("v_max_f32_e32 %0, %1, %2":"=v"(r):"v"(a),"v"(b));return r;}
__device__ __forceinline__ float fadd_s(float a,float b){float r;asm("v_add_f32_e32 %0, %1, %2":"=v"(r):"v"(a),"v"(b));return r;}
__device__ __forceinline__ float fsub_s(float a,float b){float r;asm("v_sub_f32_e32 %0, %1, %2":"=v"(r):"v"(a),"v"(b));return r;}
typedef float f32x2_t __attribute__((ext_vector_type(2))); typedef __bf16 bf16x2_t __attribute__((ext_vector_type(2)));
__device__ __forceinline__ unsigned cvtpk_s(float lo,float hi){f32x2_t v={lo,hi};bf16x2_t b=__builtin_convertvector(v,bf16x2_t);return __builtin_bit_cast(unsigned,b);}
#define WAIT_BAR(N) asm volatile("s_waitcnt vmcnt(" #N ") lgkmcnt(0)\n\ts_barrier":::"memory")

typedef unsigned u32x2_t __attribute__((ext_vector_type(2)));
#define KXFRAG(w) __builtin_bit_cast(bf16x8,(u32x4){(w)[0],(w)[1],0x0000BF80u,0u})
__device__ __forceinline__ void qkt(f32x16&p0,f32x16&p1,const char*Kslot,const char*KXslot,const bf16x8*qr,const bf16x8 qxf,int r32,int hi){
  const char*kb=Kslot+hi*1024+r32*16;
  const f32x16 z16=f32x16{};
  #pragma unroll
  for(int d0=0;d0<4;++d0){
    const bf16x8 b0=*reinterpret_cast<const bf16x8*>(kb+d0*2048);
    const bf16x8 b1=*reinterpret_cast<const bf16x8*>(kb+d0*2048+512);
    if(d0==0){p0=__builtin_amdgcn_mfma_f32_32x32x16_bf16(b0,qr[0],z16,0,0,0);p1=__builtin_amdgcn_mfma_f32_32x32x16_bf16(b1,qr[0],z16,0,0,0);}
    else{p0=__builtin_amdgcn_mfma_f32_32x32x16_bf16(b0,qr[d0],p0,0,0,0);p1=__builtin_amdgcn_mfma_f32_32x32x16_bf16(b1,qr[d0],p1,0,0,0);}}
  const u32x2_t w0=*reinterpret_cast<const u32x2_t*>(KXslot+r32*8), w1=*reinterpret_cast<const u32x2_t*>(KXslot+r32*8+256);
  p0=__builtin_amdgcn_mfma_f32_32x32x16_bf16(KXFRAG(w0),qxf,p0,0,0,0);p1=__builtin_amdgcn_mfma_f32_32x32x16_bf16(KXFRAG(w1),qxf,p1,0,0,0);
}
typedef __attribute__((address_space(3))) const char* lds_cptr;
typedef short v4i16_t __attribute__((ext_vector_type(4)));
__device__ __forceinline__ void kload8(bf16x8*kf,lds_cptr kp){
  kf[0]=*(const __attribute__((address_space(3))) bf16x8*)(kp);      kf[1]=*(const __attribute__((address_space(3))) bf16x8*)(kp+512);
  kf[2]=*(const __attribute__((address_space(3))) bf16x8*)(kp+2048); kf[3]=*(const __attribute__((address_space(3))) bf16x8*)(kp+2560);
  kf[4]=*(const __attribute__((address_space(3))) bf16x8*)(kp+4096); kf[5]=*(const __attribute__((address_space(3))) bf16x8*)(kp+4608);
  kf[6]=*(const __attribute__((address_space(3))) bf16x8*)(kp+6144); kf[7]=*(const __attribute__((address_space(3))) bf16x8*)(kp+6656);
}
__device__ __forceinline__ void kload2(bf16x8*kf,lds_cptr kp,int j){ kf[2*j]=*(const __attribute__((address_space(3))) bf16x8*)(kp+j*2048); kf[2*j+1]=*(const __attribute__((address_space(3))) bf16x8*)(kp+j*2048+512); }
__device__ __forceinline__ s16x4 vtr(lds_cptr p){ return __builtin_bit_cast(s16x4,__builtin_amdgcn_ds_read_tr16_b64_v4i16((__attribute__((address_space(3))) v4i16_t*)p)); }
__device__ __forceinline__ float rowmax(const f32x16&p0,const f32x16&p1){
  float a=max3f(p0[0],p0[1],p1[0]),b=max3f(p0[2],p0[3],p1[1]);a=max3f(a,p1[2],p1[3]);
  #pragma unroll
  for(int r=4;r<16;r+=4){a=max3f(a,p0[r],p0[r+1]);b=max3f(b,p0[r+2],p0[r+3]);a=max3f(a,p1[r],p1[r+1]);b=max3f(b,p1[r+2],p1[r+3]);}
  const float m=max2f(a,b);
  auto rr=__builtin_amdgcn_permlane32_swap(__float_as_uint(m),__float_as_uint(m),false,false);
  return max2f(__uint_as_float(rr[0]),__uint_as_float(rr[1]));
}
__device__ __forceinline__ void pv(f32x16*o,int vb,bf16x8 pa0,bf16x8 pa1,bf16x8 pa2,bf16x8 pa3){
  #pragma unroll
  for(int d0=0;d0<2;++d0){s16x4 lo[4],hi[4];
    #pragma unroll
    for(int ks=0;ks<4;++ks){
      asm volatile("ds_read_b64_tr_b16 %0,%1 offset:%c2":"=&v"(lo[ks]):"v"(vb),"i"(d0*4096+ks*1024):"memory");
      asm volatile("ds_read_b64_tr_b16 %0,%1 offset:%c2":"=&v"(hi[ks]):"v"(vb),"i"(d0*4096+ks*1024+512):"memory");}
    asm volatile("s_waitcnt lgkmcnt(0)":::"memory");SBAR();
    #define PK(k) (bf16x8){lo[k][0],lo[k][1],lo[k][2],lo[k][3],hi[k][0],hi[k][1],hi[k][2],hi[k][3]}
    o[d0]=__builtin_amdgcn_mfma_f32_32x32x16_bf16(pa0,PK(0),o[d0],0,0,0);
    o[d0]=__builtin_amdgcn_mfma_f32_32x32x16_bf16(pa1,PK(1),o[d0],0,0,0);
    o[d0]=__builtin_amdgcn_mfma_f32_32x32x16_bf16(pa2,PK(2),o[d0],0,0,0);
    o[d0]=__builtin_amdgcn_mfma_f32_32x32x16_bf16(pa3,PK(3),o[d0],0,0,0);
    #undef PK
  }
}

#ifndef ATTN_STORE16
#define ATTN_STORE16(p,v) (*(u32x4*)(p)=(v))
#endif
template<int THRL> __device__ __forceinline__ void attn_unit(int b,int h,int qb,int NTE,const bf16*Q,const bf16*__restrict__ K,const bf16*__restrict__ V,const unsigned*__restrict__ KX,bf16*O,char*shm){
  const int tid=threadIdx.x,lane=tid&63,r32=lane&31,hi=lane>>5; const int wid=__builtin_amdgcn_readfirstlane(tid>>6);
  const long rowbase=(long)b*SEQ; const int q0=qb*QB;
  const bf16*Qw=Q+(rowbase+q0+wid*QBLK)*DM+h*D;
  const bf16*Kh=K+rowbase*DM+h*D,*Vh=V+rowbase*DM+h*D;
  const unsigned lds0=(unsigned)(uintptr_t)shm;
  float*wsf=(float*)(shm+LDS_WS)+wid*64;
  const bf16*ksrc=Kh+(long)lane*DM+wid*8;
  const bf16*vsrc=Vh+(long)(16*(wid&3)+(lane>>2))*DM+(wid>>2)*32+(lane&3)*8;
  const unsigned kdst=lds0+LDS_K+wid*1024, vdst=lds0+LDS_V+wid*1024, kxdst=lds0+LDS_KX;
  const char*kxsrc=(const char*)KX+((long)(b*NHEAD+h)*SEQ)*8+(lane&31)*16;
  #define TILE(t) (((t)<4)?(NT-4+(t)):(NT-1-(t)))
  #define DMA_K(t,slot) glds16(ksrc+(long)TILE(t)*KVBLK*DM,(unsigned)__builtin_amdgcn_readfirstlane(kdst+(slot)))
  #define DMA_V(t,slot) glds16(vsrc+(long)TILE(t)*KVBLK*DM,(unsigned)__builtin_amdgcn_readfirstlane(vdst+(slot)))
  #define DMA_KX(t,slot) do{ if(wid==0) glds16(kxsrc+(long)TILE(t)*KVBLK*8,(unsigned)__builtin_amdgcn_readfirstlane(kxdst+((slot)>>3))); }while(0)
  const int vb0=(int)(lds0+LDS_V)+((lane>>4)&1)*32+(lane&3)*8+(4*hi+((lane&15)>>2))*64;
  const char*Kbase=shm+LDS_K; bf16x8 kf[8];
  const lds_cptr shm3=(lds_cptr)shm; const lds_cptr kxp0=shm3+LDS_KX+r32*8; const lds_cptr kp0=shm3+LDS_K+hi*1024+r32*16; const lds_cptr vp0=shm3+LDS_V+((lane>>4)&1)*32+(lane&3)*8+(4*hi+((lane&15)>>2))*64;
  const int NT=(q0+QB)/KVBLK;
  DMA_KX(0,0);DMA_KX(1,SLOTB);DMA_KX(2,2*SLOTB);
  DMA_K(0,0);DMA_V(0,0);DMA_K(1,SLOTB);
  bf16x8 qr[4];
  #pragma unroll
  for(int d0=0;d0<4;++d0)qr[d0]=*reinterpret_cast<const bf16x8*>(&Qw[(long)r32*DM+d0*16+hi*8]);
  float mhat=0.f,l_reg=0.f;f32x16 o[2];o[0]=f32x16{};o[1]=f32x16{};
  unsigned qx0=hi?0u:0x3F803F80u,qx1=hi?0u:0x00003F80u,qx2=0u;
  u32x2_t kxw0,kxw1;
  #define QXF __builtin_bit_cast(bf16x8,(u32x4){qx0,qx1,qx2,0u})
  #define SETREF(DL,DLE) do{ const float tgt_=mhat+(DL); const unsigned ph_=cvtpk_s(tgt_,0.f)&0xffffu; const float fh_=__uint_as_float(ph_<<16); \
    const unsigned pl_=cvtpk_s(tgt_-fh_,0.f)&0xffffu; const float mnew_=fh_+__uint_as_float(pl_<<16); DLE=mnew_-mhat; mhat=mnew_; \
    qx1=hi?0u:(0x3F80u|(ph_<<16)); qx2=hi?0u:pl_; }while(0)
  const int qrel=wid*QBLK+r32;
  #define CMASK(P0,P1,t) do{ if((t)<4)cmask(P0,P1,(t),qrel,hi); }while(0)
  bool resc=false;
  #define START(P0,P1) do{ const float rm=rowmax(P0,P1); resc=false; \
    { float dl; SETREF(rm,dl); \
      _Pragma("unroll") for(int r=0;r<16;++r){P0[r]=fsub_s(P0[r],dl);P1[r]=fsub_s(P1[r],dl);} } \
    _Pragma("unroll") for(int r=0;r<16;++r)P0[r]=__builtin_amdgcn_exp2f(P0[r]); }while(0)
  #define RESC() do{ if(resc){ asm volatile("s_waitcnt lgkmcnt(0)":::"memory"); \
      _Pragma("unroll") for(int d_=0;d_<2;++d_) _Pragma("unroll") for(int r=0;r<16;++r)o[d_][r]*=wsf[crow(r,hi)]; } }while(0)
  f32x16 pA0,pA1,pB0,pB1;
  int sl_prev=0,sl_cur=0,sl_next=SLOTB;
  #define ROT() do{sl_prev=sl_cur;sl_cur=sl_next;sl_next=(sl_next==(NSLOT-1)*SLOTB)?0:sl_next+SLOTB;}while(0)
  DMA_K(2,2*SLOTB);
  WAIT_BAR(3);
  qkt(pA0,pA1,Kbase,shm+LDS_KX,qr,QXF,r32,hi);asm volatile("s_nop 15\n\ts_nop 7":"+v"(pA0),"+v"(pA1));CMASK(pA0,pA1,0);
  START(pA0,pA1);
  _Pragma("unroll") for(int r=0;r<16;++r)pA1[r]=__builtin_amdgcn_exp2f(pA1[r]);
  WAIT_BAR(0);
  DMA_KX(3,0);DMA_K(3,0);DMA_V(1,SLOTB);
  ROT();
  kload8(kf,kp0+sl_cur); kxw0=*(const __attribute__((address_space(3))) u32x2_t*)(kxp0+(sl_cur>>3)); kxw1=*(const __attribute__((address_space(3))) u32x2_t*)(kxp0+(sl_cur>>3)+256);
  WAIT_BAR(2);
  s16x4 vlo[8],vhi[8]; u32x4 pw0,pw1,pw2,pw3;
  #define PKW(P,B) cvtpk_s(P[B],P[B+1])
  #define PAF(k) __builtin_bit_cast(bf16x8,pw##k)
  #define VFR(i) (bf16x8){vlo[i][0],vlo[i][1],vlo[i][2],vlo[i][3],vhi[i][0],vhi[i][1],vhi[i][2],vhi[i][3]}
  #define PIN(x) asm volatile("":"+v"(x))
  #define MX3(a,b,c) __builtin_fmaxf(__builtin_fmaxf((a),(b)),(c))
  #define GAPA(MF,A0,A1,A2,A3,W0,W1,PW) do{ MF; sacc+=A0; sacc+=A1; sacc+=A2; sacc+=A3; PIN(sacc); W0; W1; PIN(PW); SBAR(); }while(0)
  #define EX(v) __builtin_amdgcn_exp2f(v)
  #define GAPB(MF,X,B) do{ MF; X[B]=EX(X[B]); X[B+1]=EX(X[B+1]); X[B+2]=EX(X[B+2]); X[B+3]=EX(X[B+3]); PIN(X); SBAR(); }while(0)
  #define VRD(i) do{ vlo[i]=vtr(vp_+(((i)>>2)*4096+((i)&3)*1024)); vhi[i]=vtr(vp_+(((i)>>2)*4096+((i)&3)*1024+512)); }while(0)
  #define KRD(G,j) do{ if(G){ kload2(kf,kp0+sl_next,j); SBAR(); } }while(0)
  #define KXRD(G) do{ if(G){ kxw0=*(const __attribute__((address_space(3))) u32x2_t*)(kxp0+(sl_next>>3)); kxw1=*(const __attribute__((address_space(3))) u32x2_t*)(kxp0+(sl_next>>3)+256); SBAR(); } }while(0)
  #define STEP(C0,C1,P0,P1,t,GK,GV,GL) do{ SBAR(); \
    const lds_cptr vp_=vp0+sl_prev; const f32x16 z16_=f32x16{}; const bf16x8 qxf_=QXF; \
    VRD(0); SBAR(); float sacc=(P0[0]+P0[1]); \
    GAPA(C0=__builtin_amdgcn_mfma_f32_32x32x16_bf16(kf[0],qr[0],z16_,0,0,0), P0[2],P0[3],P0[4],P0[5],     pw0[0]=PKW(P0,0), pw0[1]=PKW(P0,2), pw0); \
    VRD(4); SBAR(); GAPA(C1=__builtin_amdgcn_mfma_f32_32x32x16_bf16(kf[1],qr[0],z16_,0,0,0), P0[6],P0[7],P0[8],P0[9],     pw0[2]=PKW(P0,4), pw0[3]=PKW(P0,6), pw0); \
    VRD(1); SBAR(); GAPA(C0=__builtin_amdgcn_mfma_f32_32x32x16_bf16(kf[2],qr[1],C0,0,0,0),   P0[10],P0[11],P0[12],P0[13], pw1[0]=PKW(P0,8), pw1[1]=PKW(P0,10), pw1); \
    VRD(5); SBAR(); GAPA(C1=__builtin_amdgcn_mfma_f32_32x32x16_bf16(kf[3],qr[1],C1,0,0,0),   P0[14],P0[15],P1[0],P1[1],   pw1[2]=PKW(P0,12),pw1[3]=PKW(P0,14), pw1); \
    VRD(2); SBAR(); GAPA(C0=__builtin_amdgcn_mfma_f32_32x32x16_bf16(kf[4],qr[2],C0,0,0,0),   P1[2],P1[3],P1[4],P1[5],     pw2[0]=PKW(P1,0), pw2[1]=PKW(P1,2), pw2); \
    VRD(6); SBAR(); GAPA(C1=__builtin_amdgcn_mfma_f32_32x32x16_bf16(kf[5],qr[2],C1,0,0,0),   P1[6],P1[7],P1[8],P1[9],     pw2[2]=PKW(P1,4), pw2[3]=PKW(P1,6), pw2); \
    VRD(3); SBAR(); GAPA(C0=__builtin_amdgcn_mfma_f32_32x32x16_bf16(kf[6],qr[3],C0,0,0,0),   P1[10],P1[11],P1[12],P1[13], pw3[0]=PKW(P1,8), pw3[1]=PKW(P1,10), pw3); \
    VRD(7); SBAR(); GAPA(C1=__builtin_amdgcn_mfma_f32_32x32x16_bf16(kf[7],qr[3],C1,0,0,0),   P1[14],P1[15],0.f,0.f,       pw3[2]=PKW(P1,12),pw3[3]=PKW(P1,14), pw3); \
    C0=__builtin_amdgcn_mfma_f32_32x32x16_bf16(KXFRAG(kxw0),qxf_,C0,0,0,0); SBAR(); C1=__builtin_amdgcn_mfma_f32_32x32x16_bf16(KXFRAG(kxw1),qxf_,C1,0,0,0); SBAR(); \
    l_reg+=sacc; \
    if(GK){DMA_KX((t)+3,sl_cur);DMA_K((t)+3,sl_cur);} if(GV){DMA_V((t)+1,sl_next);} \
    CMASK(C0,C1,t); \
    { float a=MX3(C0[0],C0[1],C1[0]),b=MX3(C0[2],C0[3],C1[1]); a=MX3(a,C1[2],C1[3]); \
      _Pragma("unroll") for(int r=4;r<16;r+=4){a=MX3(a,C0[r],C0[r+1]);b=MX3(b,C0[r+2],C0[r+3]);a=MX3(a,C1[r],C1[r+1]);b=MX3(b,C1[r+2],C1[r+3]);} \
      float rm=__builtin_fmaxf(a,b); { auto rr=__builtin_amdgcn_permlane32_swap(__float_as_uint(rm),__float_as_uint(rm),false,false); rm=__builtin_fmaxf(__uint_as_float(rr[0]),__uint_as_float(rr[1])); } \
      resc=false; \
      if(__builtin_expect(__any(rm>(float)THRL),0)){ float dl; SETREF(__builtin_fmaxf(rm,0.f),dl); \
        _Pragma("unroll") for(int r=0;r<16;++r){C0[r]-=dl;C1[r]-=dl;} \
        const float f=__builtin_amdgcn_exp2f(-dl); l_reg*=f; if(hi==0)wsf[r32]=f; resc=true; } } \
    SBAR(); \
    GAPB(o[0]=__builtin_amdgcn_mfma_f32_32x32x16_bf16(PAF(0),VFR(0),o[0],0,0,0), C0,0); \
    GAPB(o[1]=__builtin_amdgcn_mfma_f32_32x32x16_bf16(PAF(0),VFR(4),o[1],0,0,0), C0,4); \
    KXRD(GL); KRD(GL,0); GAPB(o[0]=__builtin_amdgcn_mfma_f32_32x32x16_bf16(PAF(1),VFR(1),o[0],0,0,0), C0,8); \
    KRD(GL,1); GAPB(o[1]=__builtin_amdgcn_mfma_f32_32x32x16_bf16(PAF(1),VFR(5),o[1],0,0,0), C0,12); \
    KRD(GL,2); GAPB(o[0]=__builtin_amdgcn_mfma_f32_32x32x16_bf16(PAF(2),VFR(2),o[0],0,0,0), C1,0); \
    KRD(GL,3); GAPB(o[1]=__builtin_amdgcn_mfma_f32_32x32x16_bf16(PAF(2),VFR(6),o[1],0,0,0), C1,4); \
    GAPB(o[0]=__builtin_amdgcn_mfma_f32_32x32x16_bf16(PAF(3),VFR(3),o[0],0,0,0), C1,8); \
    GAPB(o[1]=__builtin_amdgcn_mfma_f32_32x32x16_bf16(PAF(3),VFR(7),o[1],0,0,0), C1,12); \
    }while(0)
  int t=1;
  #define ENDW(tt) do{ if((tt)+3<NTE){WAIT_BAR(2);} else if((tt)+2<NTE){WAIT_BAR(1);} else {WAIT_BAR(0);} }while(0)
  for(;t+1<NTE;t+=2){
    if(t>=5){
      #undef CMASK
      #define CMASK(P0,P1,t) do{}while(0)
      for(;t+5<NTE;t+=2){
        STEP(pB0,pB1,pA0,pA1,t,true,true,true);     WAIT_BAR(2); RESC(); ROT();
        STEP(pA0,pA1,pB0,pB1,t+1,true,true,true);   WAIT_BAR(2); RESC(); ROT();
      }
      #undef CMASK
      #define CMASK(P0,P1,t) do{ if((t)<4)cmask(P0,P1,(t),qrel,hi); }while(0)
      if(!(t+1<NTE))break;
    }
    STEP(pB0,pB1,pA0,pA1,t,(t+3<NTE),(t+1<NTE),(t+1<NTE));       ENDW(t);   RESC(); ROT();
    STEP(pA0,pA1,pB0,pB1,t+1,(t+4<NTE),(t+2<NTE),(t+2<NTE));     ENDW(t+1); RESC(); ROT();
  }
  STEP(pB0,pB1,pA0,pA1,NTE-1,false,false,false); RESC();
  { float sacc=pB0[0]+pB0[1]; _Pragma("unroll") for(int r=2;r<16;++r)sacc+=pB0[r]; _Pragma("unroll") for(int r=0;r<16;++r)sacc+=pB1[r]; l_reg+=sacc;
    pw0=(u32x4){PKW(pB0,0),PKW(pB0,2),PKW(pB0,4),PKW(pB0,6)};pw1=(u32x4){PKW(pB0,8),PKW(pB0,10),PKW(pB0,12),PKW(pB0,14)};pw2=(u32x4){PKW(pB1,0),PKW(pB1,2),PKW(pB1,4),PKW(pB1,6)};pw3=(u32x4){PKW(pB1,8),PKW(pB1,10),PKW(pB1,12),PKW(pB1,14)};
    SBAR(); pv(o,vb0+sl_cur,PAF(0),PAF(1),PAF(2),PAF(3)); }
  #undef PKW
  #undef PAF
  #undef VFR
  #undef PIN
  #undef MX3
  #undef GAPA
  #undef GAPB
  #undef EX
  #undef VRD
  #undef KRD
  #undef KXRD
  #undef STEP
  #undef ENDW
  {auto rr=__builtin_amdgcn_permlane32_swap(__float_as_uint(l_reg),__float_as_uint(l_reg),false,false);l_reg=__uint_as_float(rr[0])+__uint_as_float(rr[1]);}
  if(hi==0)wsf[32+r32]=l_reg;asm volatile("s_waitcnt lgkmcnt(0)":::"memory");
  float rli[16];
  #pragma unroll
  for(int r=0;r<16;++r)rli[r]=__builtin_amdgcn_rcpf(wsf[32+crow(r,hi)]);
  bf16*Ow=O+(rowbase+q0+wid*QBLK)*DM+h*D;
  { bf16*stg=(bf16*)(shm+LDS_OST)+wid*2048;
    #pragma unroll
    for(int r=0;r<16;++r){const int orow=crow(r,hi);
      #pragma unroll
      for(int d0=0;d0<2;++d0)stg[orow*64+d0*32+r32]=__float2bfloat16(o[d0][r]*rli[r]);}
    asm volatile("s_waitcnt lgkmcnt(0)":::"memory");
    #pragma unroll
    for(int i=0;i<4;++i){const int row=i*8+(lane>>3),ch=lane&7; const u32x4 v=*(const u32x4*)(stg+row*64+ch*8); ATTN_STORE16(Ow+(long)row*DM+ch*8,v);} }
  asm volatile("s_waitcnt lgkmcnt(0)\n\ts_barrier":::"memory");
  #undef DMA_K
  #undef DMA_V
  #undef DMA_KX
  #undef TILE
  #undef QXF
  #undef SETREF
  #undef CMASK
  #undef START
  #undef RESC
  #undef ROT
}
constexpr int ATTN_LDS_BYTES=LDS_BYTES;
struct AttnTensors { const bf16* Q; const bf16* K; const bf16* V; const unsigned* KX; bf16* O; };
struct AttnUnit { int bh; int qb; };
struct AttnQueue { unsigned* ctr; const float* BIAS; const float* NORM; int nunits; };
template<int THRL=8> __device__ __forceinline__ void attn_phase(char*lds,volatile __attribute__((address_space(3))) unsigned* bc,const AttnTensors&T,const AttnQueue&Qu){
  const int lane=threadIdx.x&63;
  for(;;){
    if(threadIdx.x==0) bc[0]=__hip_atomic_fetch_add(Qu.ctr,1u,__ATOMIC_RELAXED,__HIP_MEMORY_SCOPE_AGENT);
    __syncthreads();
    const int u=(int)bc[0];
    if(u>=Qu.nunits)break;
    const int uu=u&511, bh=uu&15, qb=31-(uu>>4), NT=4*qb+4;
    const float pq=Qu.NORM[bh*2], pk=Qu.NORM[bh*2+1];
    const float thr=153.f+4.08f*sqrtf(pq*pk);
    const float* B=Qu.BIAS+(long)bh*SEQ; const float b0=B[qb*QB];
    const bool n0=(lane<NT)&&!(b0-B[64*lane+63]>thr), n1=(lane+64<NT)&&!(b0-B[64*(lane+64)+63]>thr);
    const unsigned long long m0=__ballot(n0), m1=__ballot(n1);
    int alo=m0?(int)__builtin_ctzll(m0):(m1?64+(int)__builtin_ctzll(m1):NT);
    if(alo>NT-4)alo=NT-4;
    int nx=NT-4-alo; nx+=nx&1;
    attn_unit<THRL>(bh/NHEAD,bh%NHEAD,qb,4+nx,T.Q,T.K,T.V,T.KX,T.O,lds);
  }
}
#undef SBAR
#undef WAIT_BAR
}
constexpr int NWAVES = 8;
#ifndef MK_N_LAUNCHES
#define MK_N_LAUNCHES 1
#endif
constexpr int NPH = 11;
constexpr int BATCH = 2, SEQ = 8192, D = 1024, T = BATCH * SEQ, NH = 8, HD = 64, AW = 512, CW = 512, CK = 31, NE = 32, TOPK = 4, DE = 1024, NMOD = 6, INC = 4616, NIN = 4608, OFF_F = 2560;
constexpr int SLOTS_MAX = T * TOPK + NE * 256, TILES_MAX = SLOTS_MAX / 256;
constexpr float RMS_EPS = 1e-5f, LN_EPS = 1e-5f, LOG2E = 1.4426950408889634f;
constexpr size_t MiB = 1u << 20;
constexpr size_t WS_CTL = 0, CTL_ZERO_BYTES = 64 * 1024;
constexpr size_t WS_MOD = 1 * MiB;
constexpr size_t WS_LF = WS_MOD + 256 * 1024;
constexpr size_t WS_KX = 2 * MiB;
constexpr size_t WS_WRT = 5 * MiB + 512 * 1024;
constexpr size_t WS_BIAS = 5 * MiB;
constexpr size_t CTL_NORM = 40960, CTL_QCTR = 40960 + 256, CTL_CVT = 40960 + 512, CTL_DONE = 40960 + 1024;
constexpr size_t WS_HIST = 3 * MiB;
constexpr size_t WS_TOPE = WS_HIST + 256 * 1024, WS_TOPG = WS_TOPE + 256 * 1024, WS_LRANK = WS_TOPG + 256 * 1024;
constexpr size_t WS_SLOT_TOK = 4 * MiB, WS_TOK_SLOT = WS_SLOT_TOK + 512 * 1024, WS_TILE_E = WS_TOK_SLOT + 256 * 1024;
constexpr size_t WS_WIN = 6 * MiB;
constexpr size_t WS_WC = 15 * MiB, WS_WA = 16 * MiB, WS_WO = 17 * MiB;
constexpr size_t WS_W1 = 20 * MiB;
constexpr size_t WS_W2 = 148 * MiB;
constexpr size_t WS_H = 212 * MiB;
constexpr size_t WS_AGLU = 244 * MiB, WS_Q = 260 * MiB, WS_K = 276 * MiB, WS_V = 292 * MiB;
constexpr size_t WS_SGC = 308 * MiB, WS_SGA = 340 * MiB;
constexpr size_t WS_ALN = 372 * MiB, WS_ATT = 388 * MiB;
constexpr size_t WS_MIX = 404 * MiB;
constexpr size_t WS_X1 = 436 * MiB;
constexpr size_t WS_HM = 500 * MiB;
constexpr size_t WS_YB = 644 * MiB;
constexpr size_t WS_END = 788 * MiB;
constexpr int CW_BAR = 1024;
constexpr int RING_BYTES = 131072;
constexpr int LDSCTL_OFF = RING_BYTES, MISC_OFF = LDSCTL_OFF + 320;
constexpr int ROWTAB_OFF = RING_BYTES + 1024, ROWTAB_UNITS = 12;
constexpr int LDS_BYTES = 147456;
static_assert(ROWTAB_OFF + ROWTAB_UNITS * 1024 <= LDS_BYTES, "LDS map");

#define GAS __attribute__((address_space(1)))
#define LAS __attribute__((address_space(3)))
typedef unsigned short bf16;
typedef unsigned v4u __attribute__((ext_vector_type(4)));
typedef unsigned v2u __attribute__((ext_vector_type(2)));
typedef float f32x4 __attribute__((ext_vector_type(4)));
typedef GAS unsigned gu32;
#define RLX_AGENT __ATOMIC_RELAXED, __HIP_MEMORY_SCOPE_AGENT
#define LDS_WAIT() asm volatile("s_waitcnt lgkmcnt(0)" ::: "memory")
#define VM_WAIT() asm volatile("s_waitcnt vmcnt(0)" ::: "memory")
__device__ __forceinline__ unsigned pk2(float lo, float hi) { return pg8::cvt_pk_bf16(lo, hi); }
__device__ __forceinline__ int fresh_lane() { int l; asm volatile("v_mbcnt_lo_u32_b32 %0, -1, 0\n\tv_mbcnt_hi_u32_b32 %0, -1, %0" : "=v"(l)); return l; }
__device__ __forceinline__ float wave_sum(float v) {
    v += __builtin_bit_cast(float, __builtin_amdgcn_update_dpp(0, __builtin_bit_cast(int, v), 0xB1, 0xF, 0xF, false));
    v += __builtin_bit_cast(float, __builtin_amdgcn_update_dpp(0, __builtin_bit_cast(int, v), 0x4E, 0xF, 0xF, false));
    v += __builtin_bit_cast(float, __builtin_amdgcn_update_dpp(0, __builtin_bit_cast(int, v), 0x141, 0xF, 0xF, false));
    v += __builtin_bit_cast(float, __builtin_amdgcn_update_dpp(0, __builtin_bit_cast(int, v), 0x140, 0xF, 0xF, false));
    v += __builtin_bit_cast(float, __builtin_amdgcn_update_dpp(0, __builtin_bit_cast(int, v), 0x142, 0xA, 0xF, false));
    v += __builtin_bit_cast(float, __builtin_amdgcn_update_dpp(0, __builtin_bit_cast(int, v), 0x143, 0xC, 0xF, false));
    return __builtin_bit_cast(float, __builtin_amdgcn_readlane(__builtin_bit_cast(int, v), 63));
}

#define XB_TMO      128
#define XB_XCNT(j)  (256  + 64 * (j))
#define XB_XSUB(j)  (1280 + 64 * (j))
#define XB_XGEN(j)  (2304 + 64 * (j))
#define XB_TOP      3328
#define XB_TOPGEN   3392
#define XCD_BAR_WORDS 3456
#define XB_SPIN_CAP (1u << 18)
__device__ __forceinline__ unsigned xb_ld(unsigned* p)              { return __hip_atomic_load(p, __ATOMIC_RELAXED, __HIP_MEMORY_SCOPE_AGENT); }
__device__ __forceinline__ unsigned xb_add(unsigned* p, unsigned v) { return __hip_atomic_fetch_add(p, v, __ATOMIC_RELAXED, __HIP_MEMORY_SCOPE_AGENT); }
__device__ __forceinline__ unsigned xb_xcc_id() { return (unsigned)__builtin_amdgcn_s_getreg((3 << 11) | 20) & 0xFu; }
#define XB_SPIN(cond, bar) do { unsigned _sp = 0; while (cond) { __builtin_amdgcn_s_sleep(1); \
    if ((++_sp & 255u) == 0u) { if (xb_ld(&(bar)[XB_TMO])) break; if (_sp > XB_SPIN_CAP) { atomicAdd(&(bar)[XB_TMO], 1u); break; } } } } while (0)
struct XcdBarrier { unsigned* bar; unsigned x; volatile LAS unsigned* st; };
__device__ __forceinline__ XcdBarrier xcd_barrier_post(unsigned* bar, volatile LAS unsigned* st) {
    XcdBarrier b; b.bar = bar; b.x = xb_xcc_id(); b.st = st;
    if (threadIdx.x == 0) (void)xb_add(&bar[XB_XCNT(b.x)], 1u);
    return b;
}
__device__ __forceinline__ void xcd_barrier_complete(unsigned* bar, unsigned x, unsigned& nloc, unsigned& nx) {
    const unsigned G = gridDim.x * gridDim.y * gridDim.z;
    unsigned sum, cnt, mine, sp = 0u;
    for (;;) {
        sum = 0u; cnt = 0u; mine = 0u;
#pragma unroll
        for (unsigned j = 0; j < 16; ++j) { const unsigned c = xb_ld(&bar[XB_XCNT(j)]); sum += c; cnt += (c > 0u) ? 1u : 0u; mine = (j == x) ? c : mine; }
        if (sum == G) break;
        __builtin_amdgcn_s_sleep(1);
        if ((++sp & 255u) == 0u) { if (xb_ld(&bar[XB_TMO])) break; if (sp > XB_SPIN_CAP) { atomicAdd(&bar[XB_TMO], 1u); break; } }
    }
    nloc = mine > 0u ? mine : 1u; nx = cnt > 0u ? cnt : 1u;
}
__device__ __forceinline__ void xcd_barrier(const XcdBarrier& b) {
    asm volatile("s_waitcnt vmcnt(0)" ::: "memory");
    __syncthreads();
    if (threadIdx.x == 0) {
        unsigned* bar = b.bar;
        __builtin_amdgcn_s_waitcnt(0);
        unsigned nloc = b.st[0], nx = b.st[1];
        if (nloc == 0u) { xcd_barrier_complete(bar, b.x, nloc, nx); b.st[0] = nloc; b.st[1] = nx; }
        const unsigned old = xb_add(&bar[XB_XSUB(b.x)], 1u);
        const unsigned gen = old / nloc;
        if (old + 1u == (gen + 1u) * nloc) {
            __builtin_amdgcn_fence(__ATOMIC_RELEASE, "agent");
            asm volatile("s_waitcnt vmcnt(0)" ::: "memory");
            const unsigned og = xb_add(&bar[XB_TOP], 1u);
            const unsigned tg = og / nx;
            if (og + 1u == (tg + 1u) * nx) xb_add(&bar[XB_TOPGEN], 1u);
            else XB_SPIN(xb_ld(&bar[XB_TOPGEN]) == tg, bar);
            __builtin_amdgcn_fence(__ATOMIC_ACQUIRE, "agent");
            xb_add(&bar[XB_XGEN(b.x)], 1u);
            asm volatile("s_waitcnt vmcnt(0)" ::: "memory");
        } else {
            XB_SPIN(xb_ld(&bar[XB_XGEN(b.x)]) == gen, bar);
            __builtin_amdgcn_fence(__ATOMIC_ACQUIRE, "agent");
            asm volatile("s_waitcnt vmcnt(0)" ::: "memory");
        }
    }
    __syncthreads();
}

struct Args { const float* in[22]; float* out; unsigned char* ws; int ph_lo, ph_hi; };

struct Frame {
    LAS unsigned char* lds; int tid, lane, wave, vcu, G; unsigned char* ws;
};

__device__ __forceinline__ void p0_mod(Frame& F, const float* c, const float* w_ada, const float* b_ada, float* mod) {
    LAS float* sc = (LAS float*)F.lds;
    LAS float* red = sc + 2048;
    for (int i = F.tid; i < 2048; i += NWAVES * 64) { const float v = c[i]; sc[i] = v * pg8::sigm(v); }
    __syncthreads();
    for (int item = F.vcu; item < (NMOD * D) / 24; item += F.G) {
        const int n0 = item * 24, col = F.tid % 24, kp = F.tid / 24;
        if (kp < 21) {
            float a0 = 0.f, a1 = 0.f;
#pragma unroll 7
            for (int k = kp; k < D; k += 21) { const float w = w_ada[(size_t)k * (NMOD * D) + n0 + col]; a0 += sc[k] * w; a1 += sc[1024 + k] * w; }
            red[kp * 24 + col] = a0; red[504 + kp * 24 + col] = a1;
        }
        __syncthreads();
        if (F.tid < 48) { const int b = F.tid / 24, cc = F.tid % 24; float s = 0.f;
            for (int j = 0; j < 21; ++j) s += red[b * 504 + j * 24 + cc];
            mod[b * (NMOD * D) + n0 + cc] = s + b_ada[n0 + cc]; }
        __syncthreads();
    }
}
__device__ __forceinline__ void tr_item(const float* W, int ldw, int col0, int k0, bf16* WT, int Kd, int drow0, LAS float* scr, int lane) {
    float v[32];
#pragma unroll
    for (int i = 0; i < 32; ++i) { const int kk = 2 * i + (lane >> 5); v[i] = W[(size_t)(k0 + kk) * ldw + col0 + (lane & 31)]; }
#pragma unroll
    for (int i = 0; i < 32; ++i) { const int kk = 2 * i + (lane >> 5); scr[kk * 33 + (lane & 31)] = v[i]; }
    LDS_WAIT(); asm volatile("" ::: "memory");
    const int c = lane & 7;
#pragma unroll
    for (int j = 0; j < 4; ++j) { const int n = (lane >> 3) + 8 * j; const LAS float* s = scr + (8 * c) * 33 + n;
        v4u o; o.x = pk2(s[0 * 33], s[1 * 33]); o.y = pk2(s[2 * 33], s[3 * 33]); o.z = pk2(s[4 * 33], s[5 * 33]); o.w = pk2(s[6 * 33], s[7 * 33]);
        *(GAS v4u*)(WT + (size_t)(drow0 + n) * Kd + k0 + 8 * c) = o; }
    LDS_WAIT(); asm volatile("" ::: "memory");
}
__device__ __forceinline__ void tr_item8(const float* W, int ldw, int col0, int k0, unsigned char* WT, int Kd, int drow0, LAS float* scr, int lane) {
    float v[32];
#pragma unroll
    for (int i = 0; i < 32; ++i) { const int kk = 2 * i + (lane >> 5); v[i] = __builtin_nontemporal_load(W + (size_t)(k0 + kk) * ldw + col0 + (lane & 31));   }
#pragma unroll
    for (int i = 0; i < 32; ++i) { const int kk = 2 * i + (lane >> 5); scr[kk * 33 + (lane & 31)] = v[i] * 32.f; }
    LDS_WAIT(); asm volatile("" ::: "memory");
    const int n = lane & 31, kh = lane >> 5; const LAS float* sp = scr + (32 * kh) * 33 + n;
    v4u o0, o1;
    o0.x = pg8::pk4_fp8(sp[0 * 33], sp[1 * 33], sp[2 * 33], sp[3 * 33]);     o0.y = pg8::pk4_fp8(sp[4 * 33], sp[5 * 33], sp[6 * 33], sp[7 * 33]);
    o0.z = pg8::pk4_fp8(sp[8 * 33], sp[9 * 33], sp[10 * 33], sp[11 * 33]);   o0.w = pg8::pk4_fp8(sp[12 * 33], sp[13 * 33], sp[14 * 33], sp[15 * 33]);
    o1.x = pg8::pk4_fp8(sp[16 * 33], sp[17 * 33], sp[18 * 33], sp[19 * 33]); o1.y = pg8::pk4_fp8(sp[20 * 33], sp[21 * 33], sp[22 * 33], sp[23 * 33]);
    o1.z = pg8::pk4_fp8(sp[24 * 33], sp[25 * 33], sp[26 * 33], sp[27 * 33]); o1.w = pg8::pk4_fp8(sp[28 * 33], sp[29 * 33], sp[30 * 33], sp[31 * 33]);
    GAS v4u* dst = (GAS v4u*)(WT + (size_t)(drow0 + n) * Kd + k0 + 32 * kh);
    dst[0] = o0; dst[1] = o1;
    LDS_WAIT(); asm volatile("" ::: "memory");
}
__device__ __forceinline__ void p0_router_w(Frame& F, const float* w_router) {
    bf16* WRT = (bf16*)(F.ws + WS_WRT);
    for (int i = F.vcu * NWAVES * 64 + F.tid; i < NE * D; i += F.G * NWAVES * 64) { const int e = i >> 10, k = i & 1023; const float w = w_router[(size_t)k * NE + e];
        const unsigned h = pk2(w, 0.f) & 0xffffu; const float fh = __builtin_bit_cast(float, h << 16); const unsigned lo = pk2(w - fh, 0.f) & 0xffffu;
        WRT[i] = (bf16)h; WRT[NE * D + i] = (bf16)lo; }
}
__device__ __forceinline__ void p0_convert(Frame& F, const float* w_in, const float* w_conv_out, const float* w_attn_out, const float* w_out, const float* w_exp_in, const float* w_exp_out) {
    LAS float* scr = (LAS float*)(F.lds + 16384 + F.wave * 12288);
    bf16* WIN = (bf16*)(F.ws + WS_WIN); bf16* WC = (bf16*)(F.ws + WS_WC); bf16* WA = (bf16*)(F.ws + WS_WA); bf16* WO = (bf16*)(F.ws + WS_WO); bf16* W1 = (bf16*)(F.ws + WS_W1); bf16* W2 = (bf16*)(F.ws + WS_W2);
    const int gw = F.vcu * NWAVES + F.wave, NGW = F.G * NWAVES;
    constexpr int I_IN = 16 * 144, I_C = 8 * 32, I_O = 16 * 32;
    constexpr int NITEMS = I_IN + 2 * I_C + I_O;
    for (int it = gw; it < NITEMS; it += NGW) {
        int r = it;
        if (r < I_IN) { const int kb = r / 144, db = r % 144; int src;
            if (db < 32) { const int tile = db >> 3, w = db & 7; src = (w < 4) ? 128 * tile + 32 * w : 512 + 128 * tile + 32 * (w - 4); }
            else if (db < 80) src = 32 * db; else src = 32 * db + 8;
            tr_item8(w_in, INC, src, 64 * kb, (unsigned char*)WIN, D, 32 * db, scr, F.lane); continue; } r -= I_IN;
        if (r < I_C) { tr_item(w_conv_out, D, 32 * (r % 32), 64 * (r / 32), WC, CW, 32 * (r % 32), scr, F.lane); continue; } r -= I_C;
        if (r < I_C) { tr_item(w_attn_out, D, 32 * (r % 32), 64 * (r / 32), WA, AW, 32 * (r % 32), scr, F.lane); continue; } r -= I_C;
        tr_item(w_out, D, 32 * (r % 32), 64 * (r / 32), WO, D, 32 * (r % 32), scr, F.lane);
    }
}
#ifndef CVT_FILL_WAVES
#define CVT_FILL_WAVES 8
#endif
constexpr int CVT_I1 = 16 * 64 * NE, CVT_I2 = 16 * 32 * NE, CVT_ITEMS = CVT_I1 + CVT_I2;
__device__ __forceinline__ void cvt_one(Frame& F, const float* w_exp_in, const float* w_exp_out, int r, LAS float* scr, int lane) {
    unsigned char* W1 = (unsigned char*)(F.ws + WS_W1); unsigned char* W2 = (unsigned char*)(F.ws + WS_W2);
    if (r < CVT_I1) { const int e = r / 1024, qq = r % 1024, kb = qq % 16, db = qq / 16, tile = db >> 3, w = db & 7; const int src = (w < 4) ? 128 * tile + 32 * w : 1024 + 128 * tile + 32 * (w - 4);
        tr_item8(w_exp_in + (size_t)e * D * 2 * DE, 2 * DE, src, 64 * kb, W1 + (size_t)e * 2 * DE * D, D, 32 * db, scr, lane); }
    else { r -= CVT_I1; const int e = r / 512, qq = r % 512, kb = qq % 16, nb = qq / 16;
        tr_item8(w_exp_out + (size_t)e * DE * D, D, 32 * nb, 64 * kb, W2 + (size_t)e * D * DE, DE, 32 * nb, scr, lane); }
}
constexpr int CVT_GRAIN = 16;
__device__ __forceinline__ void cvt_fill(Frame& F, const float* w_exp_in, const float* w_exp_out, int phase_tag, volatile LAS unsigned* misc, int limit = CVT_ITEMS) {
    LAS float* scr = (LAS float*)(F.lds + F.wave * 12288);
    gu32* ctr = (gu32*)(F.ws + WS_CTL + CTL_CVT); gu32* done = (gu32*)(F.ws + WS_CTL + CTL_DONE) + 64 * phase_tag;
    const int lane = fresh_lane();
    if (phase_tag && F.wave >= CVT_FILL_WAVES) return;
    unsigned base1 = misc[16 + 2 * F.wave], pos = misc[17 + 2 * F.wave];
    for (;;) {
        if (phase_tag) {
            if (F.wave == 0) { if ((unsigned)__builtin_amdgcn_readfirstlane((int)__hip_atomic_load(done, RLX_AGENT)) >= (unsigned)F.G) misc[2] = (unsigned)phase_tag; }
            if (misc[2] == (unsigned)phase_tag) break;
        }
        if (base1 == 0u) {
            unsigned it = 0; if (lane == 0) it = __hip_atomic_fetch_add(ctr, (unsigned)CVT_GRAIN, RLX_AGENT);
            it = (unsigned)__builtin_amdgcn_readfirstlane((int)it);
            if (it >= (unsigned)CVT_ITEMS) break;
            base1 = it + 1u; pos = 0u;
            if (!phase_tag && it >= (unsigned)limit) break;
        }
        cvt_one(F, w_exp_in, w_exp_out, (int)(base1 - 1u + pos), scr, lane);
        if (++pos == (unsigned)CVT_GRAIN) base1 = 0u;
    }
    if (lane == 0) { misc[16 + 2 * F.wave] = base1; misc[17 + 2 * F.wave] = pos; }
}
__device__ __forceinline__ void phase_main_done(Frame& F, int phase_tag) {
    if (F.tid == 0) (void)__hip_atomic_fetch_add((gu32*)(F.ws + WS_CTL + CTL_DONE) + 64 * phase_tag, 1u, RLX_AGENT);
}
__device__ __forceinline__ float log_sigmoid_f(float x) { return fminf(x, 0.f) - log1pf(expf(-fabsf(x))); }
__device__ __forceinline__ void p1_norm1(Frame& F, const float* x, const float* g, const float* mod, const float* w_in, const float* b_forget) {
    LAS f32x4* wf = (LAS f32x4*)F.lds;
    for (int i = F.tid; i < 2048; i += NWAVES * 64) { const int k = i >> 1, h4 = i & 1; const int j = k >> 8, l = (k & 255) >> 2, c = k & 3;
        wf[((j * 4 + c) * 2 + h4) * 64 + l] = *(const f32x4*)(w_in + (size_t)k * INC + OFF_F + 4 * h4); }
    __syncthreads();
    bf16* H = (bf16*)(F.ws + WS_H); float* LF = (float*)(F.ws + WS_LF);
    const int gw = F.vcu * NWAVES + F.wave, NGW = F.G * NWAVES, l = F.lane;
    const float bfl = b_forget[l & 7];
    constexpr int RPW = 8;
    for (int m0 = gw * RPW; m0 < T; m0 += NGW * RPW) {
        const int b = m0 / SEQ;
        const float* sh = mod + (size_t)b * NMOD * D; const float* sc = sh + D;
        f32x4 gs[4], s0[4];
#pragma unroll
        for (int j = 0; j < 4; ++j) { const int k0 = 256 * j + 4 * l; gs[j] = *(const f32x4*)(g + k0) * (*(const f32x4*)(sc + k0) + 1.f); s0[j] = *(const f32x4*)(sh + k0); }
        f32x4 nx[4];
#pragma unroll
        for (int j = 0; j < 4; ++j) nx[j] = __builtin_nontemporal_load((const f32x4*)(x + (size_t)m0 * D + 256 * j + 4 * l));
#pragma unroll 1
        for (int i = 0; i < RPW; ++i) {
            const int m = m0 + i, t = m % SEQ;
            f32x4 v[4]; float ss = 0.f;
#pragma unroll
            for (int j = 0; j < 4; ++j) { v[j] = nx[j]; ss += (v[j].x * v[j].x + v[j].y * v[j].y) + (v[j].z * v[j].z + v[j].w * v[j].w); }
            if (i + 1 < RPW) {
#pragma unroll
                for (int j = 0; j < 4; ++j) nx[j] = __builtin_nontemporal_load((const f32x4*)(x + (size_t)(m + 1) * D + 256 * j + 4 * l));
            }
            const float rstd = rsqrtf(wave_sum(ss) * (1.f / D) + RMS_EPS);
            float fl[8];
#pragma unroll
            for (int hh = 0; hh < 8; ++hh) fl[hh] = 0.f;
#pragma unroll
            for (int j = 0; j < 4; ++j) { f32x4 hv = v[j] * rstd * gs[j] + s0[j]; v[j] = hv;
#pragma unroll
                for (int c = 0; c < 4; ++c) { const f32x4 w0 = wf[((j * 4 + c) * 2 + 0) * 64 + l], w1 = wf[((j * 4 + c) * 2 + 1) * 64 + l]; const float hc = hv[c];
                    fl[0] += hc * w0.x; fl[1] += hc * w0.y; fl[2] += hc * w0.z; fl[3] += hc * w0.w; fl[4] += hc * w1.x; fl[5] += hc * w1.y; fl[6] += hc * w1.z; fl[7] += hc * w1.w; } }
            GAS unsigned* o4 = (GAS unsigned*)((unsigned char*)H + (size_t)m * D) + l;
#pragma unroll
            for (int j = 0; j < 4; ++j) o4[64 * j] = pg8::pk4_fp8(v[j].x, v[j].y, v[j].z, v[j].w);
            float mine = 0.f;
#pragma unroll
            for (int hh = 0; hh < 8; ++hh) { const float s = wave_sum(fl[hh]); mine = ((l & 7) == hh) ? s : mine; }
            const float ls = log_sigmoid_f(mine + bfl);
            if (l < 8) LF[(size_t)(b * NH + l) * SEQ + t] = ls;
        }
    }
    __syncthreads();
}
__device__ __forceinline__ void p2_fscan(Frame& F, int bh) {
    LAS double* part = (LAS double*)F.lds;
    const float* LF = (const float*)(F.ws + WS_LF) + (size_t)bh * SEQ; v2u* KX = (v2u*)(F.ws + WS_KX) + (size_t)bh * SEQ; float* BIAS = (float*)(F.ws + WS_BIAS) + (size_t)bh * SEQ;
    const int i = F.tid;
    double loc[16]; double run = 0.0;
#pragma unroll
    for (int q = 0; q < 4; ++q) { const f32x4 v = *(const f32x4*)(LF + i * 16 + 4 * q);
        run += (double)v.x; loc[4 * q] = run; run += (double)v.y; loc[4 * q + 1] = run; run += (double)v.z; loc[4 * q + 2] = run; run += (double)v.w; loc[4 * q + 3] = run; }
    part[i] = run; __syncthreads();
    for (int o = 1; o < 512; o <<= 1) { const double pv = (i >= o) ? part[i - o] : 0.0; __syncthreads(); part[i] += pv; __syncthreads(); }
    const double base = (i > 0) ? part[i - 1] : 0.0;
#pragma unroll
    for (int j = 0; j < 16; ++j) { const float bias = (float)(-(base + loc[j]) * 1.4426950408889634);
        const unsigned ph = pk2(bias, 0.f) & 0xffffu; const float fh = __builtin_bit_cast(float, ph << 16);
        const float r1 = bias - fh; const unsigned pm = pk2(r1, 0.f) & 0xffffu; const float fm = __builtin_bit_cast(float, pm << 16);
        const unsigned pl = pk2(r1 - fm, 0.f) & 0xffffu;
        v2u o; o.x = ph | (pm << 16); o.y = pl | 0xBF800000u; KX[i * 16 + j] = o; BIAS[i * 16 + j] = bias; }
    __syncthreads();
}
__device__ __forceinline__ f32x4 ld4bf(const bf16* p) { const v2u w = *(const v2u*)p; return (f32x4){pg8::bf_lo(w.x), pg8::bf_hi(w.x), pg8::bf_lo(w.y), pg8::bf_hi(w.y)}; }
__device__ __forceinline__ float dppf(float v, const int ctrl_tag) {
    const int x = __builtin_bit_cast(int, v);
    return __builtin_bit_cast(float, ctrl_tag == 0 ? __builtin_amdgcn_update_dpp(0, x, 0xB1, 0xF, 0xF, false) : ctrl_tag == 1 ? __builtin_amdgcn_update_dpp(0, x, 0x4E, 0xF, 0xF, false)
                                   : ctrl_tag == 2 ? __builtin_amdgcn_update_dpp(0, x, 0x141, 0xF, 0xF, false) : __builtin_amdgcn_update_dpp(0, x, 0x140, 0xF, 0xF, false));
}
__device__ __forceinline__ int dppi(int x, const int ctrl_tag) {
    return ctrl_tag == 0 ? __builtin_amdgcn_update_dpp(0, x, 0xB1, 0xF, 0xF, false) : ctrl_tag == 1 ? __builtin_amdgcn_update_dpp(0, x, 0x4E, 0xF, 0xF, false)
         : ctrl_tag == 2 ? __builtin_amdgcn_update_dpp(0, x, 0x141, 0xF, 0xF, false) : __builtin_amdgcn_update_dpp(0, x, 0x140, 0xF, 0xF, false);
}
template <int N, int SZ> __device__ __forceinline__ void tr_step(float (&v)[SZ], int l) {
    if constexpr (N == 32 || N == 16) {
        const bool up = (l & N) != 0;
#pragma unroll
        for (int i = 0; i < N; ++i) { const float a = v[i], bb = v[i + N]; const float mine = up ? bb : a, other = up ? a : bb; v[i] = mine + __shfl_xor(other, N); }
    } else {
        const bool up = (l & N) != 0; constexpr int tag = (N == 8) ? 3 : (N == 4) ? 2 : (N == 2) ? 1 : 0;
#pragma unroll
        for (int i = 0; i < N; ++i) { const float a = v[i], bb = v[i + N]; const float mine = up ? bb : a, other = up ? a : bb; v[i] = mine + dppf(other, tag); }
    }
}
__device__ __forceinline__ float dot2c(float acc, unsigned a, unsigned b) { asm("v_dot2c_f32_bf16 %0, %1, %2" : "+v"(acc) : "v"(a), "v"(b)); return acc; }
__device__ __forceinline__ void p3_conv(Frame& F, const float* conv_w, const float* conv_b, const float* ln_g, const float* ln_b, volatile LAS unsigned* misc, int nrep) {
    LAS float* part = (LAS float*)F.lds;
    LAS unsigned short* ain = (LAS unsigned short*)(F.lds + 4096);
    LAS unsigned short* aout = (LAS unsigned short*)(F.lds + 4096 + 62 * 1024);
    const bf16* AGLU = (const bf16*)(F.ws + WS_AGLU); bf16* ALN = (bf16*)(F.ws + WS_ALN);
    const int l = fresh_lane(), c = 64 * F.wave + l;
    unsigned wE[16], wO[16];
    { float w[31];
#pragma unroll
      for (int j = 0; j < CK; ++j) w[j] = conv_w[j * CW + c];
#pragma unroll
      for (int q = 0; q < 15; ++q) wE[q] = pk2(w[2 * q], w[2 * q + 1]);
      wE[15] = pk2(w[30], 0.f); wO[0] = pk2(0.f, w[0]);
#pragma unroll
      for (int q = 1; q < 16; ++q) wO[q] = pk2(w[2 * q - 1], w[2 * q]); }
    const float cb = conv_b[c], lg = ln_g[c], lb = ln_b[c];
    gu32* qc = (gu32*)(F.ws + WS_CTL + CTL_QCTR) + 1;
    for (;;) {
        __syncthreads();
        if (F.tid == 0) misc[1] = __hip_atomic_fetch_add(qc, 1u, RLX_AGENT);
        __syncthreads();
        const int it_ = (int)misc[1]; if (it_ >= nrep * (T / 32)) break;
        const int item = it_ % (T / 32);
        const int r0 = item * 32, tt0 = r0 % SEQ;
        for (int i = F.tid; i < 62 * 64; i += NWAVES * 64) { const int rr = i >> 6, cc = i & 63; v4u v = (v4u){0u, 0u, 0u, 0u};
            if (tt0 + rr - 30 >= 0) v = *(const v4u*)(AGLU + (size_t)(r0 + rr - 30) * CW + cc * 8);
            *(LAS v4u*)(ain + rr * 512 + cc * 8) = v; }
        __syncthreads();
        unsigned A[31];
#pragma unroll
        for (int p2 = 0; p2 < 31; ++p2) A[p2] = (unsigned)ain[(2 * p2) * 512 + c] | ((unsigned)ain[(2 * p2 + 1) * 512 + c] << 16);
        float y[32];
#pragma unroll
        for (int R2 = 0; R2 < 16; ++R2) { float e = cb, o = cb;
#pragma unroll
            for (int q = 0; q < 16; ++q) { e = dot2c(e, A[R2 + q], wE[q]); o = dot2c(o, A[R2 + q], wO[q]); }
            asm volatile("s_nop 4" : "+v"(e), "+v"(o));
            y[2 * R2] = e; y[2 * R2 + 1] = o; }
        float s1[32], s2[32];
#pragma unroll
        for (int r = 0; r < 32; ++r) { s1[r] = y[r]; s2[r] = y[r] * y[r]; }
        tr_step<16, 32>(s1, l); tr_step<8, 32>(s1, l); tr_step<4, 32>(s1, l); tr_step<2, 32>(s1, l); tr_step<1, 32>(s1, l);
        tr_step<16, 32>(s2, l); tr_step<8, 32>(s2, l); tr_step<4, 32>(s2, l); tr_step<2, 32>(s2, l); tr_step<1, 32>(s2, l);
        float t1 = s1[0] + __shfl_xor(s1[0], 32), t2 = s2[0] + __shfl_xor(s2[0], 32);
        if (l < 32) { part[(F.wave * 32 + l) * 2] = t1; part[(F.wave * 32 + l) * 2 + 1] = t2; }
        __syncthreads();
        t1 = 0.f; t2 = 0.f;
#pragma unroll
        for (int w = 0; w < 8; ++w) { t1 += part[(w * 32 + (l & 31)) * 2]; t2 += part[(w * 32 + (l & 31)) * 2 + 1]; }
        const float mean_l = t1 * (1.f / CW), rstd_l = rsqrtf(fmaxf(t2 * (1.f / CW) - mean_l * mean_l, 0.f) + LN_EPS);
#pragma unroll
        for (int r = 0; r < 32; ++r) {
            const float mean = __builtin_bit_cast(float, __builtin_amdgcn_readlane(__builtin_bit_cast(int, mean_l), r)), rstd = __builtin_bit_cast(float, __builtin_amdgcn_readlane(__builtin_bit_cast(int, rstd_l), r));
            const float v = (y[r] - mean) * rstd * lg + lb; const float z = v * pg8::sigm(v);
            aout[r * 512 + c] = (unsigned short)(pk2(z, 0.f) & 0xffffu);
        }
        __syncthreads();
        for (int i = F.tid; i < 32 * 64; i += NWAVES * 64) { const int rr = i >> 6, cc = i & 63; *(GAS v4u*)(ALN + (size_t)(r0 + rr) * CW + cc * 8) = *(const LAS v4u*)(aout + rr * 512 + cc * 8); }
    }
    __syncthreads();
}
typedef float f32x16_t __attribute__((ext_vector_type(16)));
__device__ __forceinline__ void p6_router(Frame& F, const bf16* x1, const float* g, const float* mod, const float* b_router) {
    LAS float* s_gs = (LAS float*)F.lds;
    LAS float* s_s0 = s_gs + 1024;
    LAS float* s_rstd = s_s0 + 1024;
    LAS float* s_part = s_rstd + 64;
    LAS float* s_log = s_part + 4 * 64 * 33;
    LAS int* lhist = (LAS int*)(F.lds + ROWTAB_OFF);
    if (F.tid < 32) lhist[F.tid] = 0;
    unsigned char* H8 = (unsigned char*)(F.ws + WS_H); int* TOPE = (int*)(F.ws + WS_TOPE); float* TOPG = (float*)(F.ws + WS_TOPG); int* LRANK = (int*)(F.ws + WS_LRANK); int* HIST = (int*)(F.ws + WS_HIST);
    const bf16* WRT = (const bf16*)(F.ws + WS_WRT);
    const int l = F.lane;
    for (int wg = blockIdx.x; wg < T / 64; wg += F.G) {
        const int b = (wg * 64) / SEQ; const float* sh = mod + (size_t)b * NMOD * D + 3 * D; const float* sc = sh + D;
        __syncthreads();
        for (int k = F.tid; k < D; k += NWAVES * 64) { s_gs[k] = g[k] * (sc[k] + 1.f); s_s0[k] = sh[k]; }
        __syncthreads();
        f32x4 gs[4], s0[4];
#pragma unroll
        for (int j = 0; j < 4; ++j) { gs[j] = *(const LAS f32x4*)(s_gs + 256 * j + 4 * l); s0[j] = *(const LAS f32x4*)(s_s0 + 256 * j + 4 * l); }
        v2u nx[8][4];
#pragma unroll
        for (int i = 0; i < 8; ++i)
#pragma unroll
            for (int j = 0; j < 4; ++j) nx[i][j] = *(const v2u*)(x1 + (size_t)(wg * 64 + F.wave * 8 + i) * D + 256 * j + 4 * l);
#pragma unroll
        for (int i = 0; i < 8; ++i) {
            const int m = wg * 64 + F.wave * 8 + i;
            f32x4 v[4]; float ss = 0.f;
#pragma unroll
            for (int j = 0; j < 4; ++j) { const v2u w = nx[i][j]; v[j] = (f32x4){pg8::bf_lo(w.x), pg8::bf_hi(w.x), pg8::bf_lo(w.y), pg8::bf_hi(w.y)}; ss += (v[j].x * v[j].x + v[j].y * v[j].y) + (v[j].z * v[j].z + v[j].w * v[j].w); }
            const float rstd = rsqrtf(wave_sum(ss) * (1.f / D) + RMS_EPS);
            if (l == 0) s_rstd[F.wave * 8 + i] = rstd;
            GAS unsigned* o4 = (GAS unsigned*)(H8 + (size_t)m * D) + l;
#pragma unroll
            for (int j = 0; j < 4; ++j) { const f32x4 hv = v[j] * rstd * gs[j] + s0[j]; o4[64 * j] = pg8::pk4_fp8(hv.x, hv.y, hv.z, hv.w); }
        }
        __syncthreads();
        {
            const int th = F.wave & 1, kq = F.wave >> 1, r32 = l & 31, hi = l >> 5;
            const float rs = s_rstd[th * 32 + r32];
            const bf16* xa = x1 + (size_t)(wg * 64 + th * 32 + r32) * D + 256 * kq + 8 * hi;
            const bf16* wb = WRT + (size_t)r32 * D + 256 * kq + 8 * hi;
            f32x16_t acc = f32x16_t{};
#pragma unroll 4
            for (int st = 0; st < 16; ++st) {
                const v4u xw = *(const v4u*)(xa + 16 * st); const v4u wh = *(const v4u*)(wb + 16 * st), wl = *(const v4u*)(wb + NE * D + 16 * st);
                const int k0 = 256 * kq + 16 * st + 8 * hi;
                const f32x4 ga = *(const LAS f32x4*)(s_gs + k0), gb = *(const LAS f32x4*)(s_gs + k0 + 4), sa = *(const LAS f32x4*)(s_s0 + k0), sb = *(const LAS f32x4*)(s_s0 + k0 + 4);
                float hv[8];
                hv[0] = pg8::bf_lo(xw.x) * rs * ga.x + sa.x; hv[1] = pg8::bf_hi(xw.x) * rs * ga.y + sa.y; hv[2] = pg8::bf_lo(xw.y) * rs * ga.z + sa.z; hv[3] = pg8::bf_hi(xw.y) * rs * ga.w + sa.w;
                hv[4] = pg8::bf_lo(xw.z) * rs * gb.x + sb.x; hv[5] = pg8::bf_hi(xw.z) * rs * gb.y + sb.y; hv[6] = pg8::bf_lo(xw.w) * rs * gb.z + sb.z; hv[7] = pg8::bf_hi(xw.w) * rs * gb.w + sb.w;
                v4u ah, al;
                ah.x = pk2(hv[0], hv[1]); ah.y = pk2(hv[2], hv[3]); ah.z = pk2(hv[4], hv[5]); ah.w = pk2(hv[6], hv[7]);
                al.x = pk2(hv[0] - pg8::bf_lo(ah.x), hv[1] - pg8::bf_hi(ah.x)); al.y = pk2(hv[2] - pg8::bf_lo(ah.y), hv[3] - pg8::bf_hi(ah.y));
                al.z = pk2(hv[4] - pg8::bf_lo(ah.z), hv[5] - pg8::bf_hi(ah.z)); al.w = pk2(hv[6] - pg8::bf_lo(ah.w), hv[7] - pg8::bf_hi(ah.w));
                const pg8::bf16x8 Ah = __builtin_bit_cast(pg8::bf16x8, ah), Al = __builtin_bit_cast(pg8::bf16x8, al), Bh = __builtin_bit_cast(pg8::bf16x8, wh), Bl = __builtin_bit_cast(pg8::bf16x8, wl);
                acc = __builtin_amdgcn_mfma_f32_32x32x16_bf16(Ah, Bh, acc, 0, 0, 0);
                acc = __builtin_amdgcn_mfma_f32_32x32x16_bf16(Ah, Bl, acc, 0, 0, 0);
                acc = __builtin_amdgcn_mfma_f32_32x32x16_bf16(Al, Bh, acc, 0, 0, 0);
            }
#pragma unroll
            for (int r = 0; r < 16; ++r) { const int tok = th * 32 + (r & 3) + 8 * (r >> 2) + 4 * hi; s_part[(kq * 64 + tok) * 33 + r32] = acc[r]; }
        }
        __syncthreads();
        for (int i = F.tid; i < 64 * 32; i += NWAVES * 64) { const int tok = i >> 5, e = i & 31;
            s_log[tok * 33 + e] = (s_part[(0 * 64 + tok) * 33 + e] + s_part[(1 * 64 + tok) * 33 + e]) + (s_part[(2 * 64 + tok) * 33 + e] + s_part[(3 * 64 + tok) * 33 + e]) + b_router[e]; }
        __syncthreads();
#pragma unroll 1
        for (int grp = 0; grp < 4; ++grp) {
            const int row = l >> 5, e0 = l & 31, tk = F.wave * 8 + grp * 2 + row, m0 = wg * 64 + F.wave * 8 + grp * 2;
            float l0 = s_log[tk * 33 + e0];
            float tv[4]; int te[4];
#pragma unroll
            for (int k = 0; k < 4; ++k) {
                float bv = l0; int bi = e0;
#pragma unroll
                for (int st = 0; st < 4; ++st) { const float ov = dppf(bv, st); const int oi = dppi(bi, st); if (ov > bv || (ov == bv && oi < bi)) { bv = ov; bi = oi; } }
                { const float ov = __shfl_xor(bv, 16); const int oi = __shfl_xor(bi, 16); if (ov > bv || (ov == bv && oi < bi)) { bv = ov; bi = oi; } }
                tv[k] = bv; te[k] = bi;
                if (bi == e0) l0 = -INFINITY;
            }
            if ((l & 31) == 0) {
                const float e1 = expf(tv[1] - tv[0]), e2 = expf(tv[2] - tv[0]), e3 = expf(tv[3] - tv[0]); const float inv = 1.f / (1.f + e1 + e2 + e3);
                const int t = m0 + row;
                *(int4*)(TOPE + t * 4) = make_int4(te[0], te[1], te[2], te[3]);
                *(float4*)(TOPG + t * 4) = make_float4(inv, e1 * inv, e2 * inv, e3 * inv);
                int4 rk; rk.x = __hip_atomic_fetch_add(&lhist[te[0]], 1, __ATOMIC_RELAXED, __HIP_MEMORY_SCOPE_WORKGROUP); rk.y = __hip_atomic_fetch_add(&lhist[te[1]], 1, __ATOMIC_RELAXED, __HIP_MEMORY_SCOPE_WORKGROUP); rk.z = __hip_atomic_fetch_add(&lhist[te[2]], 1, __ATOMIC_RELAXED, __HIP_MEMORY_SCOPE_WORKGROUP); rk.w = __hip_atomic_fetch_add(&lhist[te[3]], 1, __ATOMIC_RELAXED, __HIP_MEMORY_SCOPE_WORKGROUP);
                *(int4*)(LRANK + t * 4) = rk;
            }
        }
        __syncthreads();
        { const int t2 = F.wave * 64 + fresh_lane();
          if (t2 < 32) { HIST[wg * 32 + t2] = lhist[t2]; lhist[t2] = 0; } }
        __syncthreads();
    }
}
__device__ __forceinline__ void p7_slots(Frame& F) {
    LAS int* s_tot = (LAS int*)F.lds; LAS int* s_pre = s_tot + 32; LAS int* s_tstart = s_tot + 64; LAS int* s_nt = s_tot + 128;
    const int* HIST = (const int*)(F.ws + WS_HIST); const int* TOPE = (const int*)(F.ws + WS_TOPE); const int* LRANK = (const int*)(F.ws + WS_LRANK);
    int* SLOT_TOK = (int*)(F.ws + WS_SLOT_TOK); int* TOK_SLOT = (int*)(F.ws + WS_TOK_SLOT); int* TILE_E = (int*)(F.ws + WS_TILE_E);
    constexpr int NBLK = T / 64;
    for (int wg = blockIdx.x; wg < NBLK; wg += F.G) {
        __syncthreads();
        if (F.tid < 256) {
            const int e = F.tid >> 3, sub = F.tid & 7; int tot = 0, pre = 0;
            for (int w = sub; w < NBLK; w += 8) { const int hcount = HIST[w * 32 + e]; tot += hcount; if (w < wg) pre += hcount; }
            tot += __shfl_xor(tot, 1); tot += __shfl_xor(tot, 2); tot += __shfl_xor(tot, 4); pre += __shfl_xor(pre, 1); pre += __shfl_xor(pre, 2); pre += __shfl_xor(pre, 4);
            if (sub == 0) { s_tot[e] = tot; s_pre[e] = pre; s_nt[e] = (tot + 255) >> 8; }
        }
        __syncthreads();
        if (F.tid == 0) { int s = 0; for (int e = 0; e < NE; ++e) { s_tstart[e] = s; s += s_nt[e]; } s_tstart[32] = s; }
        __syncthreads();
        if (F.tid < 256) { const int idx = wg * 256 + F.tid; const int e = TOPE[idx]; const int slot = 256 * s_tstart[e] + s_pre[e] + LRANK[idx]; TOK_SLOT[idx] = slot; SLOT_TOK[slot] = idx >> 2; }
        if (wg < NE) { const int e = wg; const int lo = 256 * s_tstart[e] + s_tot[e], hi = 256 * (s_tstart[e] + s_nt[e]); for (int s = lo + F.tid; s < hi; s += NWAVES * 64) SLOT_TOK[s] = 0; }
        if (wg == 0) { if (F.tid < NE) { for (int i = 0; i < s_nt[F.tid]; ++i) TILE_E[16 + s_tstart[F.tid] + i] = F.tid; } if (F.tid == 0) TILE_E[0] = s_tstart[32]; }
    }
    __syncthreads();
}
__device__ __forceinline__ void p10_final(Frame& F, const float* mod, const float* final_g, float* out) {
    const bf16* X1 = (const bf16*)(F.ws + WS_X1); const bf16* YB = (const bf16*)(F.ws + WS_YB); const int* TOK_SLOT = (const int*)(F.ws + WS_TOK_SLOT); const float* TOPG = (const float*)(F.ws + WS_TOPG);
    const int gw = F.vcu * NWAVES + F.wave, NGW = F.G * NWAVES, l = fresh_lane();
    for (int m = gw; m < T; m += NGW) {
        const int b = m / SEQ; const float* g2 = mod + (size_t)b * NMOD * D + 5 * D;
        const int4 sl = *(const int4*)(TOK_SLOT + m * 4); const float4 gt = *(const float4*)(TOPG + m * 4);
        const int s4[4] = {sl.x, sl.y, sl.z, sl.w}; const float g4[4] = {gt.x, gt.y, gt.z, gt.w};
        float y[16];
#pragma unroll
        for (int i = 0; i < 16; ++i) y[i] = 0.f;
#pragma unroll
        for (int k = 0; k < 4; ++k)
#pragma unroll
            for (int j = 0; j < 2; ++j) { const v4u a = *(const v4u*)(YB + (size_t)s4[k] * DE + 512 * j + 8 * l);
                y[8 * j + 0] += g4[k] * pg8::bf_lo(a.x); y[8 * j + 1] += g4[k] * pg8::bf_hi(a.x); y[8 * j + 2] += g4[k] * pg8::bf_lo(a.y); y[8 * j + 3] += g4[k] * pg8::bf_hi(a.y);
                y[8 * j + 4] += g4[k] * pg8::bf_lo(a.z); y[8 * j + 5] += g4[k] * pg8::bf_hi(a.z); y[8 * j + 6] += g4[k] * pg8::bf_lo(a.w); y[8 * j + 7] += g4[k] * pg8::bf_hi(a.w); }
        float ss = 0.f;
#pragma unroll
        for (int j = 0; j < 2; ++j) { const v4u xw = *(const v4u*)(X1 + (size_t)m * D + 512 * j + 8 * l);
            const float xf[8] = {pg8::bf_lo(xw.x), pg8::bf_hi(xw.x), pg8::bf_lo(xw.y), pg8::bf_hi(xw.y), pg8::bf_lo(xw.z), pg8::bf_hi(xw.z), pg8::bf_lo(xw.w), pg8::bf_hi(xw.w)};
#pragma unroll
            for (int q = 0; q < 2; ++q) { const int k0 = 512 * j + 8 * l + 4 * q; const f32x4 gv = *(const f32x4*)(g2 + k0);
                y[8 * j + 4 * q + 0] = xf[4 * q + 0] + gv.x * y[8 * j + 4 * q + 0]; y[8 * j + 4 * q + 1] = xf[4 * q + 1] + gv.y * y[8 * j + 4 * q + 1]; y[8 * j + 4 * q + 2] = xf[4 * q + 2] + gv.z * y[8 * j + 4 * q + 2]; y[8 * j + 4 * q + 3] = xf[4 * q + 3] + gv.w * y[8 * j + 4 * q + 3];
                ss += (y[8 * j + 4 * q] * y[8 * j + 4 * q] + y[8 * j + 4 * q + 1] * y[8 * j + 4 * q + 1]) + (y[8 * j + 4 * q + 2] * y[8 * j + 4 * q + 2] + y[8 * j + 4 * q + 3] * y[8 * j + 4 * q + 3]); } }
        const float rstd = rsqrtf(wave_sum(ss) * (1.f / D) + RMS_EPS);
#pragma unroll
        for (int j = 0; j < 2; ++j)
#pragma unroll
            for (int q = 0; q < 2; ++q) { const int k0 = 512 * j + 8 * l + 4 * q; const f32x4 fg = *(const f32x4*)(final_g + k0);
                f32x4 o; o.x = y[8 * j + 4 * q] * rstd * fg.x; o.y = y[8 * j + 4 * q + 1] * rstd * fg.y; o.z = y[8 * j + 4 * q + 2] * rstd * fg.z; o.w = y[8 * j + 4 * q + 3] * rstd * fg.w;
                *(GAS f32x4*)(out + (size_t)m * D + k0) = o; }
    }
}
__global__ void __launch_bounds__(NWAVES * 64, 2) mk_fwd(Args args) {
    extern __shared__ __attribute__((aligned(16))) unsigned char lds[];
    Frame F;
    F.lds = (LAS unsigned char*)lds; F.ws = args.ws;
    F.tid = threadIdx.x; F.lane = F.tid & 63; F.wave = __builtin_amdgcn_readfirstlane(F.tid >> 6);
    F.G = gridDim.x; { const int bx = blockIdx.x; F.vcu = (F.G % 8 == 0) ? (bx % 8) * (F.G / 8) + bx / 8 : bx; }
    volatile LAS unsigned* MISC = (volatile LAS unsigned*)(F.lds + MISC_OFF);
    for (int u = F.tid; u < (ROWTAB_OFF - LDSCTL_OFF) / 4; u += NWAVES * 64) ((LAS unsigned*)(F.lds + LDSCTL_OFF))[u] = 0u;
    __syncthreads();
    XcdBarrier bar; bar.bar = (unsigned*)(args.ws + WS_CTL) + CW_BAR; bar.x = 0; bar.st = nullptr;
    if (MK_N_LAUNCHES == 1) bar = xcd_barrier_post((unsigned*)(args.ws + WS_CTL) + CW_BAR, MISC + 8);
    const int lo = args.ph_lo, hi = args.ph_hi;
#define IN(k) (lo <= (k) && (k) < hi)
#define SEAM(k) do { if (IN(k) && IN((k) + 1)) xcd_barrier(bar); } while (0)
    const float* x = args.in[0]; const float* mod = (const float*)(args.ws + WS_MOD);
    unsigned char* ws = args.ws;

    if (IN(0)) { { p0_mod(F, args.in[1], args.in[2], args.in[3], (float*)(ws + WS_MOD)); p0_router_w(F, args.in[15]); p0_convert(F, args.in[5], args.in[11], args.in[12], args.in[13], args.in[17], args.in[19]); } SEAM(0); }
    if (IN(1)) { { p1_norm1(F, x, args.in[4], mod, args.in[5], args.in[6]); } SEAM(1); }
    if (IN(2)) { {
        for (int bh = blockIdx.x; bh < BATCH * NH; bh += F.G) p2_fscan(F, bh);
        pg8::DenseSched S; S.init(ws + WS_H, ws + WS_WIN, T, NIN, D / 2, F.G, (int)blockIdx.x);
        static_assert(WS_K - WS_Q == WS_V - WS_K, "q|k|v spacing");
        pg8::EpiIn E{(bf16*)(ws + WS_AGLU), (bf16*)(ws + WS_Q), (bf16*)(ws + WS_SGC), (WS_K - WS_Q) / 2, (WS_SGA - WS_SGC) / 2, attn_body::C2, (unsigned*)(ws + WS_CTL + CTL_NORM), SEQ, 0.03125f};
        pg8::gemm_phase8<pg8::EpiIn, pg8::DenseSched, true>(F.lds, D / 2, S, E); }
        phase_main_done(F, 2); cvt_fill(F, args.in[17], args.in[19], 2, MISC);
        SEAM(2);
    }
    if (IN(3)) {
        static_assert(attn_body::ATTN_LDS_BYTES <= RING_BYTES, "attention LDS");
        const attn_body::AttnTensors AT{(const attn_body::bf16*)(ws + WS_Q), (const attn_body::bf16*)(ws + WS_K), (const attn_body::bf16*)(ws + WS_V), (const unsigned*)(ws + WS_KX), (attn_body::bf16*)(ws + WS_ATT)};
        const attn_body::AttnQueue AQ{(unsigned*)(ws + WS_CTL + CTL_QCTR), (const float*)(ws + WS_BIAS), (const float*)(ws + WS_CTL + CTL_NORM), 512};
        attn_body::attn_phase<8>((char*)lds, MISC, AT, AQ);
        p3_conv(F, args.in[7], args.in[8], args.in[9], args.in[10], MISC, 1);
        phase_main_done(F, 3); cvt_fill(F, args.in[17], args.in[19], 3, MISC);
        SEAM(3);
    }
    if (IN(4)) { {
        pg8::PairSched S{(const char*)(ws + WS_ALN), (const char*)(ws + WS_WC), (const char*)(ws + WS_ATT), (const char*)(ws + WS_WA), CW, T / 256, D / 256, (T / 256) * (D / 256), F.G, (int)blockIdx.x};
        pg8::EpiMix E{(const bf16*)(ws + WS_SGC), (WS_SGA - WS_SGC) / 2, (bf16*)(ws + WS_MIX)};
        pg8::gemm_phase<pg8::EpiMix, pg8::PairSched, true>(F.lds, CW, S, E); }
        SEAM(4);
    }
    if (IN(5)) { {
        pg8::DenseSched S; S.init(ws + WS_MIX, ws + WS_WO, T, D, D, F.G, (int)blockIdx.x);
        pg8::EpiRes E{x, mod + 2 * D, (bf16*)(ws + WS_X1), SEQ, NMOD * D};
        pg8::gemm_phase<pg8::EpiRes, pg8::DenseSched, false>(F.lds, D, S, E); }
        SEAM(5);
    }
    if (IN(6)) { { p6_router(F, (const bf16*)(ws + WS_X1), args.in[14], mod, args.in[16]); } SEAM(6); }
    if (IN(7)) { { p7_slots(F); } cvt_fill(F, args.in[17], args.in[19], 0, MISC); SEAM(7); }
    if (IN(8)) { {
        const int* TILE_E = (const int*)(ws + WS_TILE_E); const int ntiles = TILE_E[0]; const int Wd = (F.G % 8 == 0) ? F.G / 8 : F.G, NG = (F.G % 8 == 0) ? 8 : 1;
        LAS int* rows = (LAS int*)(F.lds + ROWTAB_OFF);
        pg8::MoeSched<8, true> S{(const char*)(ws + WS_H), (const char*)(ws + WS_W1), TILE_E + 16, D / 2, 8 * ntiles, (8 * ntiles + NG - 1) / NG, F.vcu / Wd, F.vcu % Wd, Wd, (size_t)2 * DE * D, rows};
        const int* SLOT_TOK = (const int*)(ws + WS_SLOT_TOK);
        for (int i = 0; i < ROWTAB_UNITS; ++i) { pg8::Unit u; if (!S.next(i, u)) break; if (F.tid < 256) rows[i * 256 + F.tid] = SLOT_TOK[u.pm * 256 + F.tid]; }
        __syncthreads();
        pg8::EpiSwiglu8 E{args.in[18], (unsigned char*)(ws + WS_HM)};
        pg8::gemm_phase8<pg8::EpiSwiglu8, pg8::MoeSched<8, true>, true>(F.lds, D / 2, S, E); }
        SEAM(8);
    }
    if (IN(9)) { {
        const int* TILE_E = (const int*)(ws + WS_TILE_E); const int ntiles = TILE_E[0]; const int Wd = (F.G % 8 == 0) ? F.G / 8 : F.G, NG = (F.G % 8 == 0) ? 8 : 1;
        pg8::MoeSched<4, false> S{(const char*)(ws + WS_HM), (const char*)(ws + WS_W2), TILE_E + 16, DE / 2, 4 * ntiles, (4 * ntiles + NG - 1) / NG, F.vcu / Wd, F.vcu % Wd, Wd, (size_t)D * DE, nullptr};
        pg8::EpiYb8 E{args.in[20], (bf16*)(ws + WS_YB)};
        pg8::gemm_phase8<pg8::EpiYb8, pg8::MoeSched<4, false>, true>(F.lds, DE / 2, S, E); }
        SEAM(9);
    }
    if (IN(10)) { { p10_final(F, mod, args.in[21], args.out); } }
#undef IN
#undef SEAM
}

extern "C" void kernel_launch(void* const* d_in, const int* in_sizes, int n_in, void* d_out, int out_size, void* d_ws, size_t ws_size, hipStream_t stream) {
    static int grid = 0;
    if (grid == 0) {
        if (n_in != 22 || in_sizes[0] != T * D || out_size != T * D || ws_size < WS_END) { fprintf(stderr, "kernel_launch: unexpected shapes / workspace (n_in %d, ws %zu); nothing launched\n", n_in, ws_size); grid = -1; return; }
        int dev = 0, cus = 0, per_cu = 0;
        if (hipGetDevice(&dev) != hipSuccess || hipDeviceGetAttribute(&cus, hipDeviceAttributeMultiprocessorCount, dev) != hipSuccess) { grid = -1; return; }
        if (hipFuncSetAttribute((const void*)mk_fwd, hipFuncAttributeMaxDynamicSharedMemorySize, LDS_BYTES) != hipSuccess) { fprintf(stderr, "kernel_launch: hipFuncSetAttribute failed\n"); grid = -1; return; }
        if (hipOccupancyMaxActiveBlocksPerMultiprocessor(&per_cu, (const void*)mk_fwd, NWAVES * 64, LDS_BYTES) != hipSuccess || per_cu < 1) fprintf(stderr, "kernel_launch: occupancy query reports %d\n", per_cu);
        (void)hipGetLastError();
        grid = cus;
    }
    if (grid < 0) return;
    if (hipMemsetAsync((char*)d_ws + WS_CTL, 0, CTL_ZERO_BYTES, stream) != hipSuccess) return;
    Args a{};
    for (int i = 0; i < 22; ++i) a.in[i] = (const float*)d_in[i];
    a.out = (float*)d_out; a.ws = (unsigned char*)d_ws;
    if (MK_N_LAUNCHES == 1) { a.ph_lo = 0; a.ph_hi = NPH; hipLaunchKernelGGL(mk_fwd, dim3(grid), dim3(NWAVES * 64), LDS_BYTES, stream, a); }
    else for (int p = 0; p < NPH; ++p) { a.ph_lo = p; a.ph_hi = p + 1; hipLaunchKernelGGL(mk_fwd, dim3(grid), dim3(NWAVES * 64), LDS_BYTES, stream, a); }
}
```

```cpp
#include <hip/hip_runtime.h>
#include <hip/hip_bf16.h>
#include <cstdio>
#include <cstdint>
#include <cmath>

namespace pg8 {
#define PG8_LAS __attribute__((address_space(3)))
typedef unsigned short bf16_t;
typedef short bf16x8 __attribute__((ext_vector_type(8)));
typedef float f32x4 __attribute__((ext_vector_type(4)));
typedef unsigned u32x4 __attribute__((ext_vector_type(4)));
typedef unsigned u32x2 __attribute__((ext_vector_type(2)));
typedef int v8i __attribute__((ext_vector_type(8)));
constexpr int BM = 256, BK = 64, HALF = 128, HTB = HALF * BK * 2  , STAGE_BYTES = 8 * HTB, NXCD = 8, WGM = 8;

__host__ __device__ __forceinline__ int lds_byte(int r, int c) { const int st = (r >> 4) * 2 + (c >> 5), rr = r & 15, cc = c & 31, ob = rr * 64 + cc * 2; return st * 1024 + (ob ^ (((ob >> 9) & 1) << 5)); }
__host__ __device__ __forceinline__ void stage_rc(int b, int& R, int& C) { const int st = b / 1024, sb = b % 1024, swz = sb ^ (((sb >> 9) & 1) << 5); R = (st >> 1) * 16 + swz / 64; C = (st & 1) * 32 + (swz % 64) / 2; }
__host__ __device__ __forceinline__ int perm32(int rho) { const int n = rho >> 4, i = rho & 15; return 8 * (i >> 2) + 4 * n + (i & 3); }

struct Unit { int pm, pn, aux, li; const char* A; const char* B; };

__device__ __forceinline__ void tile_of(int L, int nM, int nN, int& pm, int& pn) {
    const int nwg = nM * nN; int wgid = L; { const int q = nwg / NXCD, r = nwg % NXCD, xcd = wgid % NXCD, off = wgid / NXCD; wgid = (xcd < r ? xcd * (q + 1) : r * (q + 1) + (xcd - r) * q) + off; }
    const int nig = WGM * nN, gid = wgid / nig, fm = gid * WGM, gsz = (nM - fm) < WGM ? (nM - fm) : WGM;
    pm = fm + ((wgid % nig) % gsz); pn = (wgid % nig) / gsz;
}
struct DenseSched {
    const char* A; const char* Bt; int K, nM, nN, nwg, G, c;
    __device__ __forceinline__ void init(const void* A_, const void* Bt_, int M, int N, int K_, int G_, int c_) { A = (const char*)A_; Bt = (const char*)Bt_; K = K_; nM = M / BM; nN = N / BM; nwg = nM * nN; G = G_; c = c_; }
    __device__ __forceinline__ bool next(int i, Unit& u) const {
        const long L = (long)i * G + c; if (L >= nwg) return false;
        tile_of((int)L, nM, nN, u.pm, u.pn); u.aux = 0; u.li = i; u.A = A + (size_t)u.pm * BM * K * 2; u.B = Bt + (size_t)u.pn * BM * K * 2; return true;
    }
    __device__ __forceinline__ void aoff(const Unit&, const int (&R)[2], const int (&Cb)[2], unsigned (&o)[2][2]) const {
#pragma unroll
        for (int h = 0; h < 2; ++h)
#pragma unroll
            for (int i = 0; i < 2; ++i) o[h][i] = (unsigned)((h * HALF + R[i]) * K * 2 + Cb[i]);
    }
};
struct PairSched {
    const char *A0, *B0, *A1, *B1; int K, nM, nN, nwg, G, c;
    __device__ __forceinline__ bool next(int i, Unit& u) const {
        const long L = (long)(i >> 1) * G + c; if (L >= nwg) return false;
        tile_of((int)L, nM, nN, u.pm, u.pn); u.aux = i & 1; u.li = i;
        u.A = ((i & 1) ? A1 : A0) + (size_t)u.pm * BM * K * 2; u.B = ((i & 1) ? B1 : B0) + (size_t)u.pn * BM * K * 2; return true;
    }
    __device__ __forceinline__ void aoff(const Unit&, const int (&R)[2], const int (&Cb)[2], unsigned (&o)[2][2]) const {
#pragma unroll
        for (int h = 0; h < 2; ++h)
#pragma unroll
            for (int i = 0; i < 2; ++i) o[h][i] = (unsigned)((h * HALF + R[i]) * K * 2 + Cb[i]);
    }
};
template <int NT_N, bool GATHER> struct MoeSched {
    const char* A; const char* W; const int* tile_e; int K, U, PER, x, r, Wd; size_t wstride_e; PG8_LAS const int* rows;
    __device__ __forceinline__ bool next(int i, Unit& u) const {
        const int q = i * Wd + r; if (q >= PER) return false; const int g = x * PER + q; if (g >= U) return false;
        const int tile = g / NT_N, pn = g % NT_N; const int e = tile_e[tile];
        u.pm = tile; u.pn = pn; u.aux = e; u.li = i; u.A = GATHER ? A : A + (size_t)tile * BM * K * 2; u.B = W + (size_t)e * wstride_e + (size_t)pn * BM * K * 2; return true;
    }
    __device__ __forceinline__ void aoff(const Unit& u, const int (&R)[2], const int (&Cb)[2], unsigned (&o)[2][2]) const {
#pragma unroll
        for (int h = 0; h < 2; ++h)
#pragma unroll
            for (int i = 0; i < 2; ++i) { const int rr = h * HALF + R[i]; o[h][i] = GATHER ? (unsigned)(rows[u.li * 256 + rr] * K * 2 + Cb[i]) : (unsigned)(rr * K * 2 + Cb[i]); }
    }
};

typedef float f32x2_c __attribute__((ext_vector_type(2))); typedef __bf16 bf16x2_c __attribute__((ext_vector_type(2)));
__device__ __forceinline__ unsigned cvt_pk_bf16(float lo, float hi) { const f32x2_c v = {lo, hi}; const bf16x2_c b = __builtin_convertvector(v, bf16x2_c); return __builtin_bit_cast(unsigned, b); }
__device__ __forceinline__ float bf_lo(unsigned u) { return __builtin_bit_cast(float, u << 16); }
__device__ __forceinline__ float bf_hi(unsigned u) { return __builtin_bit_cast(float, u & 0xffff0000u); }
__device__ __forceinline__ float sigm(float x) { return __builtin_amdgcn_rcpf(1.f + __builtin_amdgcn_exp2f(-1.4426950408889634f * x)); }

typedef f32x4 Acc[2][2][4][2];

struct EpiIn {
    static constexpr bool PERM = true;
    struct Pre { int none; };
    __device__ __forceinline__ Pre pre(const Unit&, int, int) const { return Pre{0}; }
    bf16_t *AGLU, *QKV, *SG; size_t qkv_stride, sg_stride; float qscale; unsigned* NORM; int rows_per_batch; float ascale;
    __device__ __forceinline__ void operator()(const Acc& acc, const Unit& u, const Pre&, int wr, int wc, int fr, int fq) const {
        const int row0 = u.pm * BM + wr * 64 + fr; const int pn = u.pn;
        if (pn < 4) {
#pragma unroll
            for (int ai = 0; ai < 2; ++ai)
#pragma unroll
                for (int m = 0; m < 4; ++m) { bf16_t* rowp = AGLU + (size_t)(row0 + ai * HALF + m * 16) * 512 + pn * 128 + wc * 32 + 8 * fq;
                    const f32x4 v0 = acc[ai][0][m][0] * ascale, v1 = acc[ai][0][m][1] * ascale, g0 = acc[ai][1][m][0] * ascale, g1 = acc[ai][1][m][1] * ascale;
                    u32x4 w; w.x = cvt_pk_bf16(v0[0] * sigm(g0[0]), v0[1] * sigm(g0[1])); w.y = cvt_pk_bf16(v0[2] * sigm(g0[2]), v0[3] * sigm(g0[3]));
                    w.z = cvt_pk_bf16(v1[0] * sigm(g1[0]), v1[1] * sigm(g1[1])); w.w = cvt_pk_bf16(v1[2] * sigm(g1[2]), v1[3] * sigm(g1[3]));
                    *(u32x4*)rowp = w; }
        } else if (pn < 10) {
            const int t = (pn - 4) >> 1; bf16_t* base = QKV + (size_t)t * qkv_stride; const float sc = ((t == 0) ? qscale : 1.f) * ascale;
            const int col0 = ((pn - 4) & 1) * 256 + wc * 32 + 8 * fq; float nmx[2] = {0.f, 0.f};
#pragma unroll
            for (int ai = 0; ai < 2; ++ai)
#pragma unroll
                for (int m = 0; m < 4; ++m) { bf16_t* rowp = base + (size_t)(row0 + ai * HALF + m * 16) * 512 + col0;
#pragma unroll
                    for (int bj = 0; bj < 2; ++bj) { const f32x4 v0 = acc[ai][bj][m][0] * sc, v1 = acc[ai][bj][m][1] * sc;
                        if (t < 2) { float ssq = (v0[0] * v0[0] + v0[1] * v0[1]) + (v0[2] * v0[2] + v0[3] * v0[3]) + (v1[0] * v1[0] + v1[1] * v1[1]) + (v1[2] * v1[2] + v1[3] * v1[3]);
                            ssq += __shfl_xor(ssq, 16); ssq += __shfl_xor(ssq, 32); nmx[bj] = fmaxf(nmx[bj], ssq); }
                        u32x4 w; w.x = cvt_pk_bf16(v0[0], v0[1]); w.y = cvt_pk_bf16(v0[2], v0[3]); w.z = cvt_pk_bf16(v1[0], v1[1]); w.w = cvt_pk_bf16(v1[2], v1[3]);
                        *(u32x4*)(rowp + bj * HALF) = w; } }
            if (t < 2) {
#pragma unroll
                for (int bj = 0; bj < 2; ++bj) { float r = nmx[bj];
#pragma unroll
                    for (int o = 1; o < 16; o <<= 1) r = fmaxf(r, __shfl_xor(r, o));
                    const int head = ((pn - 4) & 1) * 4 + bj * 2 + (wc >> 1), bb = (u.pm * BM) / rows_per_batch;
                    if ((threadIdx.x & 63) == 0) atomicMax(NORM + (bb * 8 + head) * 2 + t, __builtin_bit_cast(unsigned, r)); } }
        } else {
            const int t = (pn - 10) >> 2; bf16_t* base = SG + (size_t)t * sg_stride; const int col0 = ((pn - 10) & 3) * 256 + wc * 32 + 8 * fq;
#pragma unroll
            for (int ai = 0; ai < 2; ++ai)
#pragma unroll
                for (int m = 0; m < 4; ++m) { bf16_t* rowp = base + (size_t)(row0 + ai * HALF + m * 16) * 1024 + col0;
#pragma unroll
                    for (int bj = 0; bj < 2; ++bj) { const f32x4 v0 = acc[ai][bj][m][0] * ascale, v1 = acc[ai][bj][m][1] * ascale;
                        u32x4 w; w.x = cvt_pk_bf16(sigm(v0[0]), sigm(v0[1])); w.y = cvt_pk_bf16(sigm(v0[2]), sigm(v0[3])); w.z = cvt_pk_bf16(sigm(v1[0]), sigm(v1[1])); w.w = cvt_pk_bf16(sigm(v1[2]), sigm(v1[3]));
                        *(u32x4*)(rowp + bj * HALF) = w; } }
        }
    }
};
struct EpiMix {
    static constexpr bool PERM = true;
    const bf16_t* SG; size_t sg_stride; bf16_t* MIX;
    __device__ __forceinline__ void operator()(const Acc& acc, const Unit& u, int wr, int wc, int fr, int fq) const {
        const int row0 = u.pm * BM + wr * 64 + fr, col0 = u.pn * BM + wc * 32 + 8 * fq; const bf16_t* G = SG + (size_t)u.aux * sg_stride;
#pragma unroll
        for (int ai = 0; ai < 2; ++ai) {
            u32x4 gq[4][2], pq[4][2];
#pragma unroll
            for (int m = 0; m < 4; ++m)
#pragma unroll
                for (int bj = 0; bj < 2; ++bj) { const size_t ro = (size_t)(row0 + ai * HALF + m * 16) * 1024 + col0 + bj * HALF; gq[m][bj] = *(const u32x4*)(G + ro); if (u.aux) pq[m][bj] = *(const u32x4*)(MIX + ro); }
            asm volatile("" ::: "memory");
#pragma unroll
            for (int m = 0; m < 4; ++m)
#pragma unroll
                for (int bj = 0; bj < 2; ++bj) { const size_t ro = (size_t)(row0 + ai * HALF + m * 16) * 1024 + col0 + bj * HALF; const u32x4 g = gq[m][bj]; const f32x4 v0 = acc[ai][bj][m][0], v1 = acc[ai][bj][m][1];
                    float o0 = bf_lo(g.x) * v0[0], o1 = bf_hi(g.x) * v0[1], o2 = bf_lo(g.y) * v0[2], o3 = bf_hi(g.y) * v0[3], o4 = bf_lo(g.z) * v1[0], o5 = bf_hi(g.z) * v1[1], o6 = bf_lo(g.w) * v1[2], o7 = bf_hi(g.w) * v1[3];
                    if (u.aux) { const u32x4 p = pq[m][bj];
                        o0 += bf_lo(p.x); o1 += bf_hi(p.x); o2 += bf_lo(p.y); o3 += bf_hi(p.y); o4 += bf_lo(p.z); o5 += bf_hi(p.z); o6 += bf_lo(p.w); o7 += bf_hi(p.w); }
                    u32x4 w; w.x = cvt_pk_bf16(o0, o1); w.y = cvt_pk_bf16(o2, o3); w.z = cvt_pk_bf16(o4, o5); w.w = cvt_pk_bf16(o6, o7);
                    *(u32x4*)(MIX + ro) = w; }
        }
    }
};
struct EpiRes {
    static constexpr bool PERM = true;
    const float* X; const float* G1; bf16_t* X1; int rows_per_batch; int gstride;
    __device__ __forceinline__ void operator()(const Acc& acc, const Unit& u, int wr, int wc, int fr, int fq) const {
        const int row0 = u.pm * BM + wr * 64 + fr, col0 = u.pn * BM + wc * 32 + 8 * fq;
        const float* g = G1 + (size_t)((u.pm * BM) / rows_per_batch) * gstride + col0;
        f32x4 gv[2][2];
#pragma unroll
        for (int bj = 0; bj < 2; ++bj)
#pragma unroll
            for (int n = 0; n < 2; ++n) gv[bj][n] = *(const f32x4*)(g + bj * HALF + 4 * n);
#pragma unroll
        for (int ai = 0; ai < 2; ++ai) {
            f32x4 xq[4][2][2];
#pragma unroll
            for (int m = 0; m < 4; ++m)
#pragma unroll
                for (int bj = 0; bj < 2; ++bj) { const size_t o = (size_t)(row0 + ai * HALF + m * 16) * 1024 + col0 + bj * HALF; xq[m][bj][0] = *(const f32x4*)(X + o); xq[m][bj][1] = *(const f32x4*)(X + o + 4); }
            asm volatile("" ::: "memory");
#pragma unroll
            for (int m = 0; m < 4; ++m)
#pragma unroll
                for (int bj = 0; bj < 2; ++bj) { const size_t o = (size_t)(row0 + ai * HALF + m * 16) * 1024 + col0 + bj * HALF;
                    const f32x4 v0 = xq[m][bj][0] + gv[bj][0] * acc[ai][bj][m][0], v1 = xq[m][bj][1] + gv[bj][1] * acc[ai][bj][m][1];
                    u32x4 w; w.x = cvt_pk_bf16(v0[0], v0[1]); w.y = cvt_pk_bf16(v0[2], v0[3]); w.z = cvt_pk_bf16(v1[0], v1[1]); w.w = cvt_pk_bf16(v1[2], v1[3]);
                    *(u32x4*)(X1 + o) = w; }
        }
    }
};
__device__ __forceinline__ unsigned pk4_fp8(float a, float b, float c, float d) { int w = 0; w = __builtin_amdgcn_cvt_pk_fp8_f32(a, b, w, false); w = __builtin_amdgcn_cvt_pk_fp8_f32(c, d, w, true); return (unsigned)w; }
typedef float f32x2 __attribute__((ext_vector_type(2)));
__device__ __forceinline__ f32x2 swiglu2(f32x2 ga, f32x2 ua, f32x2 bg, f32x2 bu) {
    f32x2 g = ga * 0.03125f + bg, u = ua * 0.03125f + bu;
    g.x = fminf(g.x, 7.f); g.y = fminf(g.y, 7.f); u.x = fminf(fmaxf(u.x, -7.f), 7.f); u.y = fminf(fmaxf(u.y, -7.f), 7.f);
    const f32x2 t = g * (-1.702f * 1.4426950408889634f);
    f32x2 e; e.x = __builtin_amdgcn_exp2f(t.x); e.y = __builtin_amdgcn_exp2f(t.y);
    const f32x2 d = e + 1.f;
    f32x2 r; r.x = __builtin_amdgcn_rcpf(d.x); r.y = __builtin_amdgcn_rcpf(d.y);
    const f32x2 s = g * r;
    return u * s + s;
}
struct EpiSwiglu8 {
    static constexpr bool PERM = true;
    const float* B1; unsigned char* HM8;
    struct Pre { f32x4 bg0, bg1, bu0, bu1; };
    __device__ __forceinline__ Pre pre(const Unit& u, int wc, int fq) const { const int colh = u.pn * 128 + wc * 32 + 8 * fq; const float* b1 = B1 + (size_t)u.aux * 2048;
        Pre p; p.bg0 = *(const f32x4*)(b1 + colh); p.bg1 = *(const f32x4*)(b1 + colh + 4); p.bu0 = *(const f32x4*)(b1 + 1024 + colh); p.bu1 = *(const f32x4*)(b1 + 1024 + colh + 4); return p; }
    __device__ __forceinline__ void operator()(const Acc& acc, const Unit& u, const Pre& P, int wr, int wc, int fr, int fq) const {
        const int row0 = u.pm * BM + wr * 64 + fr, colh = u.pn * 128 + wc * 32 + 8 * fq;
        const f32x4 bg0 = P.bg0, bg1 = P.bg1, bu0 = P.bu0, bu1 = P.bu1;
#pragma unroll
        for (int ai = 0; ai < 2; ++ai)
#pragma unroll
            for (int m = 0; m < 4; ++m) { unsigned char* rowp = HM8 + (size_t)(row0 + ai * HALF + m * 16) * 1024 + colh;
                const f32x4 ga0 = acc[ai][0][m][0], ga1 = acc[ai][0][m][1], ua0 = acc[ai][1][m][0], ua1 = acc[ai][1][m][1];
                const f32x2 o0 = swiglu2(ga0.xy, ua0.xy, bg0.xy, bu0.xy), o1 = swiglu2(ga0.zw, ua0.zw, bg0.zw, bu0.zw), o2 = swiglu2(ga1.xy, ua1.xy, bg1.xy, bu1.xy), o3 = swiglu2(ga1.zw, ua1.zw, bg1.zw, bu1.zw);
                const float o[8] = {o0.x, o0.y, o1.x, o1.y, o2.x, o2.y, o3.x, o3.y};
                u32x2 w; w.x = pk4_fp8(o[0], o[1], o[2], o[3]); w.y = pk4_fp8(o[4], o[5], o[6], o[7]);
                *(u32x2*)rowp = w; }
    }
};
struct EpiYb8 {
    static constexpr bool PERM = true;
    const float* B2; bf16_t* YB;
    struct Pre { f32x4 bv[2][2]; };
    __device__ __forceinline__ Pre pre(const Unit& u, int wc, int fq) const { const float* b2 = B2 + (size_t)u.aux * 1024 + u.pn * BM + wc * 32 + 8 * fq; Pre p;
#pragma unroll
        for (int bj = 0; bj < 2; ++bj)
#pragma unroll
            for (int n = 0; n < 2; ++n) p.bv[bj][n] = *(const f32x4*)(b2 + bj * HALF + 4 * n);
        return p; }
    __device__ __forceinline__ void operator()(const Acc& acc, const Unit& u, const Pre& P, int wr, int wc, int fr, int fq) const {
        const int row0 = u.pm * BM + wr * 64 + fr, col0 = u.pn * BM + wc * 32 + 8 * fq;
#pragma unroll
        for (int ai = 0; ai < 2; ++ai)
#pragma unroll
            for (int m = 0; m < 4; ++m) { bf16_t* rowp = YB + (size_t)(row0 + ai * HALF + m * 16) * 1024 + col0;
#pragma unroll
                for (int bj = 0; bj < 2; ++bj) { const f32x4 v0 = acc[ai][bj][m][0] * 0.03125f + P.bv[bj][0], v1 = acc[ai][bj][m][1] * 0.03125f + P.bv[bj][1];
                    u32x4 w; w.x = cvt_pk_bf16(v0[0], v0[1]); w.y = cvt_pk_bf16(v0[2], v0[3]); w.z = cvt_pk_bf16(v1[0], v1[1]); w.w = cvt_pk_bf16(v1[2], v1[3]);
                    *(u32x4*)(rowp + bj * HALF) = w; } }
    }
};


template <class Epi, class Sched, bool ALIGN_EPI>
__device__ __forceinline__ void gemm_phase(PG8_LAS unsigned char* lds, const int K, const Sched& S, const Epi& E) {
    const int tid = threadIdx.x, wid = __builtin_amdgcn_readfirstlane(tid >> 6), lane = tid & 63, wr = wid >> 2, wc = wid & 3, fr = lane & 15, fq = lane >> 4;
    const int nt = K / BK;
    int R[2], Cb[2]; unsigned voffB[2];
#pragma unroll
    for (int i = 0; i < 2; ++i) { int R_, C_; stage_rc(tid * 16 + i * 8192, R_, C_); const int Rb = Epi::PERM ? ((R_ & ~31) + perm32(R_ & 31)) : R_;
        R[i] = R_; Cb[i] = C_ * 2; voffB[i] = (unsigned)(Rb * K + C_) * 2u; }
    const size_t kstep = (size_t)(BK * 2);
    const size_t hstep = (size_t)HALF * K * 2;
    const unsigned ldsw = (unsigned)wid * 1024u;
    const int aoffl = lds_byte(wr * 64 + fr, fq * 8), boffl = lds_byte(wc * 32 + fr, fq * 8);
#define PG8_SA(b, h) (((b) * 2 + (h)) * HTB)
#define PG8_SB(b, h) ((4 + (b) * 2 + (h)) * HTB)
#define PG8_STAGE_B(bufoff, gbase) do { _Pragma("unroll") for (int _i = 0; _i < 2; ++_i) \
        __builtin_amdgcn_global_load_lds((const unsigned*)((const char*)(gbase) + voffB[_i]), (PG8_LAS unsigned*)(lds + (bufoff) + ldsw + _i * 8192), 16, 0, 0); } while (0)
#define PG8_STAGE_A(bufoff, gbase, o0, o1) do { \
        __builtin_amdgcn_global_load_lds((const unsigned*)((const char*)(gbase) + (o0)), (PG8_LAS unsigned*)(lds + (bufoff) + ldsw), 16, 0, 0); \
        __builtin_amdgcn_global_load_lds((const unsigned*)((const char*)(gbase) + (o1)), (PG8_LAS unsigned*)(lds + (bufoff) + ldsw + 8192), 16, 0, 0); } while (0)
#define PG8_LDA(dst, b, h) do { _Pragma("unroll") for (int m = 0; m < 4; ++m) _Pragma("unroll") for (int k = 0; k < 2; ++k) dst[m][k] = *(const PG8_LAS bf16x8*)(lds + PG8_SA(b, h) + aoffl + m * 2048 + k * 1024); } while (0)
#define PG8_LDB(dst, b, h) do { _Pragma("unroll") for (int n = 0; n < 2; ++n) _Pragma("unroll") for (int k = 0; k < 2; ++k) dst[n][k] = *(const PG8_LAS bf16x8*)(lds + PG8_SB(b, h) + boffl + n * 2048 + k * 1024); } while (0)
#define PG8_MMA(ai, bj, At, Bt) do { __builtin_amdgcn_s_setprio(1); _Pragma("unroll") for (int m = 0; m < 4; ++m) _Pragma("unroll") for (int n = 0; n < 2; ++n) _Pragma("unroll") for (int k = 0; k < 2; ++k) \
        acc[ai][bj][m][n] = __builtin_amdgcn_mfma_f32_16x16x32_bf16(Bt[n][k], At[m][k], acc[ai][bj][m][n], 0, 0, 0); __builtin_amdgcn_s_setprio(0); } while (0)
#define PG8_WAIT_V(n) asm volatile("s_waitcnt vmcnt(" #n ")" ::: "memory")
#define PG8_WAIT_L(n) asm volatile("s_waitcnt lgkmcnt(" #n ")" ::: "memory")
#define PG8_BAR __builtin_amdgcn_s_barrier()
#define PG8_SCHED __builtin_amdgcn_sched_barrier(0)
    Unit cur, nxt; int ui = 0;
    if (!S.next(0, cur)) return;
    Acc acc;
#pragma unroll
    for (int a = 0; a < 2; ++a)
#pragma unroll
        for (int b = 0; b < 2; ++b)
#pragma unroll
            for (int m = 0; m < 4; ++m)
#pragma unroll
                for (int n = 0; n < 2; ++n) acc[a][b][m][n] = (f32x4){0.f, 0.f, 0.f, 0.f};
    bf16x8 At[4][2], B0[2][2], B1[2][2];
    unsigned oa[2][2], na[2][2];
    S.aoff(cur, R, Cb, oa);
    const char* cA = cur.A; const char* cB = cur.B;
    PG8_STAGE_B(PG8_SB(0, 0), cB); PG8_STAGE_B(PG8_SB(0, 1), cB + hstep); PG8_STAGE_A(PG8_SA(0, 0), cA, oa[0][0], oa[0][1]); PG8_STAGE_A(PG8_SA(0, 1), cA, oa[1][0], oa[1][1]);
    if (wr == 1) PG8_BAR;
    PG8_WAIT_V(2); PG8_BAR;
    PG8_STAGE_B(PG8_SB(1, 0), cB + kstep); PG8_STAGE_A(PG8_SA(1, 0), cA + kstep, oa[0][0], oa[0][1]); PG8_STAGE_B(PG8_SB(1, 1), cB + hstep + kstep);
    PG8_WAIT_V(6); PG8_BAR;
    for (;;) {
        const bool has_next = S.next(ui + 1, nxt);
        if (has_next) S.aoff(nxt, R, Cb, na);
        else {
#pragma unroll
            for (int h = 0; h < 2; ++h)
#pragma unroll
                for (int i = 0; i < 2; ++i) na[h][i] = oa[h][i];
        }
        const char* nA = has_next ? nxt.A : cA; const char* nB = has_next ? nxt.B : cB;
        for (int t = 0; t < nt; t += 2) {
            const bool last = (t == nt - 2);
            const char* a1 = cA + (size_t)(t + 1) * kstep;
            const char* a2 = last ? nA : cA + (size_t)(t + 2) * kstep; const char* b2 = last ? nB : cB + (size_t)(t + 2) * kstep;
            const char* a3 = a2 + kstep; const char* b3 = b2 + kstep;
            const unsigned p00 = last ? na[0][0] : oa[0][0], p01 = last ? na[0][1] : oa[0][1], p10 = last ? na[1][0] : oa[1][0], p11 = last ? na[1][1] : oa[1][1];
            PG8_LDB(B0, 0, 0); PG8_LDB(B1, 0, 1); PG8_SCHED; PG8_LDA(At, 0, 0); PG8_STAGE_A(PG8_SA(1, 1), a1, oa[1][0], oa[1][1]);
            PG8_WAIT_V(8); PG8_WAIT_L(0); PG8_BAR; PG8_MMA(0, 0, At, B0); PG8_MMA(0, 1, At, B1); PG8_BAR; PG8_SCHED;
            PG8_LDA(At, 0, 1); PG8_STAGE_B(PG8_SB(0, 0), b2); PG8_STAGE_B(PG8_SB(0, 1), b2 + hstep); PG8_STAGE_A(PG8_SA(0, 0), a2, p00, p01);
            PG8_WAIT_V(8); PG8_WAIT_L(0); PG8_BAR; PG8_MMA(1, 0, At, B0); PG8_MMA(1, 1, At, B1); PG8_BAR; PG8_SCHED;
            PG8_LDB(B0, 1, 0); PG8_LDB(B1, 1, 1); PG8_SCHED; PG8_LDA(At, 1, 0); PG8_STAGE_A(PG8_SA(0, 1), a2, p10, p11);
            PG8_WAIT_V(8); PG8_WAIT_L(0); PG8_BAR; PG8_MMA(0, 0, At, B0); PG8_MMA(0, 1, At, B1); PG8_BAR; PG8_SCHED;
            PG8_LDA(At, 1, 1); PG8_STAGE_B(PG8_SB(1, 0), b3); PG8_STAGE_B(PG8_SB(1, 1), b3 + hstep); PG8_STAGE_A(PG8_SA(1, 0), a3, p00, p01);
            PG8_WAIT_V(8); PG8_WAIT_L(0); PG8_BAR; PG8_MMA(1, 0, At, B0); PG8_MMA(1, 1, At, B1); PG8_BAR; PG8_SCHED;
        }
        if constexpr (ALIGN_EPI) { if (wr == 0) PG8_BAR; }
        E(acc, cur, wr, wc, fr, fq);
        if (!has_next) break;
#pragma unroll
        for (int a = 0; a < 2; ++a)
#pragma unroll
            for (int b = 0; b < 2; ++b)
#pragma unroll
                for (int m = 0; m < 4; ++m)
#pragma unroll
                    for (int n = 0; n < 2; ++n) acc[a][b][m][n] = (f32x4){0.f, 0.f, 0.f, 0.f};
        cur = nxt; cA = nA; cB = nB; ++ui;
#pragma unroll
        for (int h = 0; h < 2; ++h)
#pragma unroll
            for (int i = 0; i < 2; ++i) oa[h][i] = na[h][i];
        if constexpr (ALIGN_EPI) { if (wr == 1) PG8_BAR; }
    }
    PG8_WAIT_V(0);
    if constexpr (!ALIGN_EPI) { if (wr == 0) PG8_BAR; }
    PG8_BAR;
#undef PG8_SA
#undef PG8_SB
#undef PG8_STAGE_A
#undef PG8_STAGE_B
#undef PG8_LDA
#undef PG8_LDB
#undef PG8_MMA
#undef PG8_WAIT_V
#undef PG8_WAIT_L
#undef PG8_BAR
#undef PG8_SCHED
}
template <class Epi, class Sched, bool ALIGN_EPI>
__device__ __forceinline__ void gemm_phase8(PG8_LAS unsigned char* lds, const int K, const Sched& S, const Epi& E) {
    const int tid = threadIdx.x, wid = __builtin_amdgcn_readfirstlane(tid >> 6), lane = tid & 63, wr = wid >> 2, wc = wid & 3, fr = lane & 15, fq = lane >> 4;
    const int nt = K / BK;
    int R[2], Cb[2]; unsigned voffB[2];
#pragma unroll
    for (int i = 0; i < 2; ++i) { int R_, C_; stage_rc(tid * 16 + i * 8192, R_, C_); const int Rb = Epi::PERM ? ((R_ & ~31) + perm32(R_ & 31)) : R_;
        R[i] = R_; Cb[i] = C_ * 2; voffB[i] = (unsigned)(Rb * K + C_) * 2u; }
    const size_t kstep = (size_t)(BK * 2);
    const size_t hstep = (size_t)HALF * K * 2;
    const unsigned ldsw = (unsigned)wid * 1024u;
    const int aoffl = lds_byte(wr * 64 + fr, fq * 16), boffl = lds_byte(wc * 32 + fr, fq * 16);
#define PG8_SA(b, h) (((b) * 2 + (h)) * HTB)
#define PG8_SB(b, h) ((4 + (b) * 2 + (h)) * HTB)
#define PG8_STAGE_B(bufoff, gbase) do { _Pragma("unroll") for (int _i = 0; _i < 2; ++_i) \
        __builtin_amdgcn_global_load_lds((const unsigned*)((const char*)(gbase) + voffB[_i]), (PG8_LAS unsigned*)(lds + (bufoff) + ldsw + _i * 8192), 16, 0, 0); } while (0)
#define PG8_STAGE_A(bufoff, gbase, o0, o1) do { \
        __builtin_amdgcn_global_load_lds((const unsigned*)((const char*)(gbase) + (o0)), (PG8_LAS unsigned*)(lds + (bufoff) + ldsw), 16, 0, 0); \
        __builtin_amdgcn_global_load_lds((const unsigned*)((const char*)(gbase) + (o1)), (PG8_LAS unsigned*)(lds + (bufoff) + ldsw + 8192), 16, 0, 0); } while (0)
#define PG8_LD32(p) __builtin_bit_cast(v8i, __builtin_shufflevector(*(const PG8_LAS bf16x8*)(p), *(const PG8_LAS bf16x8*)((p) + 16), 0, 1, 2, 3, 4, 5, 6, 7, 8, 9, 10, 11, 12, 13, 14, 15))
#define PG8_LDA(dst, b, h) do { _Pragma("unroll") for (int m = 0; m < 4; ++m) dst[m] = PG8_LD32(lds + PG8_SA(b, h) + aoffl + m * 2048); } while (0)
#define PG8_LDB(dst, b, h) do { _Pragma("unroll") for (int n = 0; n < 2; ++n) dst[n] = PG8_LD32(lds + PG8_SB(b, h) + boffl + n * 2048); } while (0)
#define PG8_MMA(ai, bj, At, Bt) do { __builtin_amdgcn_s_setprio(1); _Pragma("unroll") for (int m = 0; m < 4; ++m) _Pragma("unroll") for (int n = 0; n < 2; ++n) \
        asm volatile("v_mfma_f32_16x16x128_f8f6f4 %0, %1, %2, %0" : "+v"(acc[ai][bj][m][n]) : "v"(Bt[n]), "v"(At[m])); __builtin_amdgcn_s_setprio(0); } while (0)
#define PG8_WAIT_V(n) asm volatile("s_waitcnt vmcnt(" #n ")" ::: "memory")
#define PG8_WAIT_L(n) asm volatile("s_waitcnt lgkmcnt(" #n ")" ::: "memory")
#define PG8_BAR __builtin_amdgcn_s_barrier()
#define PG8_SCHED __builtin_amdgcn_sched_barrier(0)
    Unit cur, nxt; int ui = 0;
    if (!S.next(0, cur)) return;
    Acc acc;
#pragma unroll
    for (int a = 0; a < 2; ++a)
#pragma unroll
        for (int b = 0; b < 2; ++b)
#pragma unroll
            for (int m = 0; m < 4; ++m)
#pragma unroll
                for (int n = 0; n < 2; ++n) acc[a][b][m][n] = (f32x4){0.f, 0.f, 0.f, 0.f};
    v8i At[4], B0[2], B1[2];
    unsigned oa[2][2], na[2][2];
    S.aoff(cur, R, Cb, oa);
    typename Epi::Pre pre = E.pre(cur, wc, fq);
    const char* cA = cur.A; const char* cB = cur.B;
    PG8_STAGE_B(PG8_SB(0, 0), cB); PG8_STAGE_B(PG8_SB(0, 1), cB + hstep); PG8_STAGE_A(PG8_SA(0, 0), cA, oa[0][0], oa[0][1]); PG8_STAGE_A(PG8_SA(0, 1), cA, oa[1][0], oa[1][1]);
    if (wr == 1) PG8_BAR;
    PG8_WAIT_V(2); PG8_BAR;
    PG8_STAGE_B(PG8_SB(1, 0), cB + kstep); PG8_STAGE_A(PG8_SA(1, 0), cA + kstep, oa[0][0], oa[0][1]); PG8_STAGE_B(PG8_SB(1, 1), cB + hstep + kstep);
    PG8_WAIT_V(6); PG8_BAR;
    for (;;) {
        const bool has_next = S.next(ui + 1, nxt);
        if (has_next) S.aoff(nxt, R, Cb, na);
        else {
#pragma unroll
            for (int h = 0; h < 2; ++h)
#pragma unroll
                for (int i = 0; i < 2; ++i) na[h][i] = oa[h][i];
        }
        const char* nA = has_next ? nxt.A : cA; const char* nB = has_next ? nxt.B : cB;
#pragma unroll 1
        for (int t = 0; t < nt; t += 2) {
            const bool last = (t == nt - 2);
            const char* a1 = cA + (size_t)(t + 1) * kstep;
            const char* a2 = last ? nA : cA + (size_t)(t + 2) * kstep; const char* b2 = last ? nB : cB + (size_t)(t + 2) * kstep;
            const char* a3 = a2 + kstep; const char* b3 = b2 + kstep;
            const unsigned p00 = last ? na[0][0] : oa[0][0], p01 = last ? na[0][1] : oa[0][1], p10 = last ? na[1][0] : oa[1][0], p11 = last ? na[1][1] : oa[1][1];
            PG8_LDB(B0, 0, 0); PG8_LDB(B1, 0, 1); PG8_SCHED; PG8_LDA(At, 0, 0); PG8_STAGE_A(PG8_SA(1, 1), a1, oa[1][0], oa[1][1]);
            PG8_WAIT_V(8); PG8_WAIT_L(0); PG8_BAR; PG8_MMA(0, 0, At, B0); PG8_MMA(0, 1, At, B1); PG8_BAR; PG8_SCHED;
            PG8_LDA(At, 0, 1); PG8_STAGE_B(PG8_SB(0, 0), b2); PG8_STAGE_B(PG8_SB(0, 1), b2 + hstep); PG8_STAGE_A(PG8_SA(0, 0), a2, p00, p01);
            PG8_WAIT_V(8); PG8_WAIT_L(0); PG8_BAR; PG8_MMA(1, 0, At, B0); PG8_MMA(1, 1, At, B1); PG8_BAR; PG8_SCHED;
            PG8_LDB(B0, 1, 0); PG8_LDB(B1, 1, 1); PG8_SCHED; PG8_LDA(At, 1, 0); PG8_STAGE_A(PG8_SA(0, 1), a2, p10, p11);
            PG8_WAIT_V(8); PG8_WAIT_L(0); PG8_BAR; PG8_MMA(0, 0, At, B0); PG8_MMA(0, 1, At, B1); PG8_BAR; PG8_SCHED;
            PG8_LDA(At, 1, 1); PG8_STAGE_B(PG8_SB(1, 0), b3); PG8_STAGE_B(PG8_SB(1, 1), b3 + hstep); PG8_STAGE_A(PG8_SA(1, 0), a3, p00, p01);
            PG8_WAIT_V(8); PG8_WAIT_L(0); PG8_BAR; PG8_MMA(1, 0, At, B0); PG8_MMA(1, 1, At, B1); PG8_BAR; PG8_SCHED;
        }
        if constexpr (ALIGN_EPI) { if (wr == 0) PG8_BAR; }
        asm volatile("s_nop 15\n\ts_nop 7" ::: "memory");
        E(acc, cur, pre, wr, wc, fr, fq);
        if (!has_next) break;
#pragma unroll
        for (int a = 0; a < 2; ++a)
#pragma unroll
            for (int b = 0; b < 2; ++b)
#pragma unroll
                for (int m = 0; m < 4; ++m)
#pragma unroll
                    for (int n = 0; n < 2; ++n) acc[a][b][m][n] = (f32x4){0.f, 0.f, 0.f, 0.f};
        cur = nxt; cA = nA; cB = nB; ++ui; pre = E.pre(cur, wc, fq);
#pragma unroll
        for (int h = 0; h < 2; ++h)
#pragma unroll
            for (int i = 0; i < 2; ++i) oa[h][i] = na[h][i];
        if constexpr (ALIGN_EPI) { if (wr == 1) PG8_BAR; }
    }
    PG8_WAIT_V(0);
    if constexpr (!ALIGN_EPI) { if (wr == 0) PG8_BAR; }
    PG8_BAR;
#undef PG8_SA
#undef PG8_SB
#undef PG8_STAGE_A
#undef PG8_STAGE_B
#undef PG8_LD32
#undef PG8_LDA
#undef PG8_LDB
#undef PG8_MMA
#undef PG8_WAIT_V
#undef PG8_WAIT_L
#undef PG8_BAR
#undef PG8_SCHED
}
}
namespace attn_body {
using bf16=__hip_bfloat16;
using bf16x8=__attribute__((ext_vector_type(8)))short;
using s16x4=__attribute__((ext_vector_type(4)))short;
using f32x16=__attribute__((ext_vector_type(16)))float;
using u32x4=__attribute__((ext_vector_type(4)))unsigned;
constexpr int BATCH=2,NHEAD=8,SEQ=8192,D=64,DM=NHEAD*D;
constexpr int NW=8,QBLK=32,QB=QBLK*NW,KVBLK=64,NQB=SEQ/QB;
constexpr int ATTN_PITCH=DM, ATTN_UNIT_ROWS=QB;
__device__ __forceinline__ int crow(int r,int hi){return (r&3)+8*(r>>2)+4*hi;}
#define SBAR() __builtin_amdgcn_sched_barrier(0)
__device__ __forceinline__ void cmask(f32x16&p0,f32x16&p1,int jb,int qrel,int hi){
  const float NEG=-INFINITY; int kb=64*jb+4*hi;
  #pragma unroll
  for(int r=0;r<16;++r){int kv=kb+(r&3)+8*(r>>2); if(kv>qrel)p0[r]=NEG; if(kv+32>qrel)p1[r]=NEG;}
}

constexpr int NSLOT=3, SLOTB=8192;
constexpr int LDS_K=0, LDS_V=NSLOT*SLOTB, LDS_WS=2*NSLOT*SLOTB, LDS_OST=LDS_WS+NW*64*4, LDS_KX=LDS_OST+NW*4096, LDS_BYTES=LDS_KX+NSLOT*1024;
constexpr float C2=0.125f*1.4426950408889634f;
__device__ __forceinline__ void glds16(const void*gsrc,unsigned lds_dst){unsigned keep;
  asm volatile("s_mov_b32 %0, m0\n\ts_mov_b32 m0, %2\n\ts_nop 0\n\tglobal_load_lds_dwordx4 %1, off\n\ts_mov_b32 m0, %0":"=&s"(keep):"v"(gsrc),"s"(lds_dst):"memory");}
__device__ __forceinline__ float max3f(float a,float b,float c){float r;asm("v_max3_f32 %0, %1, %2, %3":"=v"(r):"v"(a),"v"(b),"v"(c));return r;}
__device__ __forceinline__ float max2f(float a,float b){float r;asm("v_max_f32_e32 %0, %1, %2":"=v"(r):"v"(a),"v"(b));return r;}
__device__ __forceinline__ float fadd_s(float a,float b){float r;asm("v_add_f32_e32 %0, %1, %2":"=v"(r):"v"(a),"v"(b));return r;}
__device__ __forceinline__ float fsub_s(float a,float b){float r;asm("v_sub_f32_e32 %0, %1, %2":"=v"(r):"v"(a),"v"(b));return r;}
typedef float f32x2_t __attribute__((ext_vector_type(2))); typedef __bf16 bf16x2_t __attribute__((ext_vector_type(2)));
__device__ __forceinline__ unsigned cvtpk_s(float lo,float hi){f32x2_t v={lo,hi};bf16x2_t b=__builtin_convertvector(v,bf16x2_t);return __builtin_bit_cast(unsigned,b);}
#define WAIT_BAR(N) asm volatile("s_waitcnt vmcnt(" #N ") lgkmcnt(0)\n\ts_barrier":::"memory")

typedef unsigned u32x2_t __attribute__((ext_vector_type(2)));
#define KXFRAG(w) __builtin_bit_cast(bf16x8,(u32x4){(w)[0],(w)[1],0x0000BF80u,0u})
__device__ __forceinline__ void qkt(f32x16&p0,f32x16&p1,const char*Kslot,const char*KXslot,const bf16x8*qr,const bf16x8 qxf,int r32,int hi){
  const char*kb=Kslot+hi*1024+r32*16;
  const f32x16 z16=f32x16{};
  #pragma unroll
  for(int d0=0;d0<4;++d0){
    const bf16x8 b0=*reinterpret_cast<const bf16x8*>(kb+d0*2048);
    const bf16x8 b1=*reinterpret_cast<const bf16x8*>(kb+d0*2048+512);
    if(d0==0){p0=__builtin_amdgcn_mfma_f32_32x32x16_bf16(b0,qr[0],z16,0,0,0);p1=__builtin_amdgcn_mfma_f32_32x32x16_bf16(b1,qr[0],z16,0,0,0);}
    else{p0=__builtin_amdgcn_mfma_f32_32x32x16_bf16(b0,qr[d0],p0,0,0,0);p1=__builtin_amdgcn_mfma_f32_32x32x16_bf16(b1,qr[d0],p1,0,0,0);}}
  const u32x2_t w0=*reinterpret_cast<const u32x2_t*>(KXslot+r32*8), w1=*reinterpret_cast<const u32x2_t*>(KXslot+r32*8+256);
  p0=__builtin_amdgcn_mfma_f32_32x32x16_bf16(KXFRAG(w0),qxf,p0,0,0,0);p1=__builtin_amdgcn_mfma_f32_32x32x16_bf16(KXFRAG(w1),qxf,p1,0,0,0);
}
typedef __attribute__((address_space(3))) const char* lds_cptr;
typedef short v4i16_t __attribute__((ext_vector_type(4)));
__device__ __forceinline__ void kload8(bf16x8*kf,lds_cptr kp){
  kf[0]=*(const __attribute__((address_space(3))) bf16x8*)(kp);      kf[1]=*(const __attribute__((address_space(3))) bf16x8*)(kp+512);
  kf[2]=*(const __attribute__((address_space(3))) bf16x8*)(kp+2048); kf[3]=*(const __attribute__((address_space(3))) bf16x8*)(kp+2560);
  kf[4]=*(const __attribute__((address_space(3))) bf16x8*)(kp+4096); kf[5]=*(const __attribute__((address_space(3))) bf16x8*)(kp+4608);
  kf[6]=*(const __attribute__((address_space(3))) bf16x8*)(kp+6144); kf[7]=*(const __attribute__((address_space(3))) bf16x8*)(kp+6656);
}
__device__ __forceinline__ void kload2(bf16x8*kf,lds_cptr kp,int j){ kf[2*j]=*(const __attribute__((address_space(3))) bf16x8*)(kp+j*2048); kf[2*j+1]=*(const __attribute__((address_space(3))) bf16x8*)(kp+j*2048+512); }
__device__ __forceinline__ s16x4 vtr(lds_cptr p){ return __builtin_bit_cast(s16x4,__builtin_amdgcn_ds_read_tr16_b64_v4i16((__attribute__((address_space(3))) v4i16_t*)p)); }
__device__ __forceinline__ float rowmax(const f32x16&p0,const f32x16&p1){
  float a=max3f(p0[0],p0[1],p1[0]),b=max3f(p0[2],p0[3],p1[1]);a=max3f(a,p1[2],p1[3]);
  #pragma unroll
  for(int r=4;r<16;r+=4){a=max3f(a,p0[r],p0[r+1]);b=max3f(b,p0[r+2],p0[r+3]);a=max3f(a,p1[r],p1[r+1]);b=max3f(b,p1[r+2],p1[r+3]);}
  const float m=max2f(a,b);
  auto rr=__builtin_amdgcn_permlane32_swap(__float_as_uint(m),__float_as_uint(m),false,false);
  return max2f(__uint_as_float(rr[0]),__uint_as_float(rr[1]));
}
__device__ __forceinline__ void pv(f32x16*o,int vb,bf16x8 pa0,bf16x8 pa1,bf16x8 pa2,bf16x8 pa3){
  #pragma unroll
  for(int d0=0;d0<2;++d0){s16x4 lo[4],hi[4];
    #pragma unroll
    for(int ks=0;ks<4;++ks){
      asm volatile("ds_read_b64_tr_b16 %0,%1 offset:%c2":"=&v"(lo[ks]):"v"(vb),"i"(d0*4096+ks*1024):"memory");
      asm volatile("ds_read_b64_tr_b16 %0,%1 offset:%c2":"=&v"(hi[ks]):"v"(vb),"i"(d0*4096+ks*1024+512):"memory");}
    asm volatile("s_waitcnt lgkmcnt(0)":::"memory");SBAR();
    #define PK(k) (bf16x8){lo[k][0],lo[k][1],lo[k][2],lo[k][3],hi[k][0],hi[k][1],hi[k][2],hi[k][3]}
    o[d0]=__builtin_amdgcn_mfma_f32_32x32x16_bf16(pa0,PK(0),o[d0],0,0,0);
    o[d0]=__builtin_amdgcn_mfma_f32_32x32x16_bf16(pa1,PK(1),o[d0],0,0,0);
    o[d0]=__builtin_amdgcn_mfma_f32_32x32x16_bf16(pa2,PK(2),o[d0],0,0,0);
    o[d0]=__builtin_amdgcn_mfma_f32_32x32x16_bf16(pa3,PK(3),o[d0],0,0,0);
    #undef PK
  }
}

#ifndef ATTN_STORE16
#define ATTN_STORE16(p,v) (*(u32x4*)(p)=(v))
#endif
template<int THRL> __device__ __forceinline__ void attn_unit(int b,int h,int qb,int NTE,const bf16*Q,const bf16*__restrict__ K,const bf16*__restrict__ V,const unsigned*__restrict__ KX,bf16*O,char*shm){
  const int tid=threadIdx.x,lane=tid&63,r32=lane&31,hi=lane>>5; const int wid=__builtin_amdgcn_readfirstlane(tid>>6);
  const long rowbase=(long)b*SEQ; const int q0=qb*QB;
  const bf16*Qw=Q+(rowbase+q0+wid*QBLK)*DM+h*D;
  const bf16*Kh=K+rowbase*DM+h*D,*Vh=V+rowbase*DM+h*D;
  const unsigned lds0=(unsigned)(uintptr_t)shm;
  float*wsf=(float*)(shm+LDS_WS)+wid*64;
  const bf16*ksrc=Kh+(long)lane*DM+wid*8;
  const bf16*vsrc=Vh+(long)(16*(wid&3)+(lane>>2))*DM+(wid>>2)*32+(lane&3)*8;
  const unsigned kdst=lds0+LDS_K+wid*1024, vdst=lds0+LDS_V+wid*1024, kxdst=lds0+LDS_KX;
  const char*kxsrc=(const char*)KX+((long)(b*NHEAD+h)*SEQ)*8+(lane&31)*16;
  #define TILE(t) (((t)<4)?(NT-4+(t)):(NT-1-(t)))
  #define DMA_K(t,slot) glds16(ksrc+(long)TILE(t)*KVBLK*DM,(unsigned)__builtin_amdgcn_readfirstlane(kdst+(slot)))
  #define DMA_V(t,slot) glds16(vsrc+(long)TILE(t)*KVBLK*DM,(unsigned)__builtin_amdgcn_readfirstlane(vdst+(slot)))
  #define DMA_KX(t,slot) do{ if(wid==0) glds16(kxsrc+(long)TILE(t)*KVBLK*8,(unsigned)__builtin_amdgcn_readfirstlane(kxdst+((slot)>>3))); }while(0)
  const int vb0=(int)(lds0+LDS_V)+((lane>>4)&1)*32+(lane&3)*8+(4*hi+((lane&15)>>2))*64;
  const char*Kbase=shm+LDS_K; bf16x8 kf[8];
  const lds_cptr shm3=(lds_cptr)shm; const lds_cptr kxp0=shm3+LDS_KX+r32*8; const lds_cptr kp0=shm3+LDS_K+hi*1024+r32*16; const lds_cptr vp0=shm3+LDS_V+((lane>>4)&1)*32+(lane&3)*8+(4*hi+((lane&15)>>2))*64;
  const int NT=(q0+QB)/KVBLK;
  DMA_KX(0,0);DMA_KX(1,SLOTB);DMA_KX(2,2*SLOTB);
  DMA_K(0,0);DMA_V(0,0);DMA_K(1,SLOTB);
  bf16x8 qr[4];
  #pragma unroll
  for(int d0=0;d0<4;++d0)qr[d0]=*reinterpret_cast<const bf16x8*>(&Qw[(long)r32*DM+d0*16+hi*8]);
  float mhat=0.f,l_reg=0.f;f32x16 o[2];o[0]=f32x16{};o[1]=f32x16{};
  unsigned qx0=hi?0u:0x3F803F80u,qx1=hi?0u:0x00003F80u,qx2=0u;
  u32x2_t kxw0,kxw1;
  #define QXF __builtin_bit_cast(bf16x8,(u32x4){qx0,qx1,qx2,0u})
  #define SETREF(DL,DLE) do{ const float tgt_=mhat+(DL); const unsigned ph_=cvtpk_s(tgt_,0.f)&0xffffu; const float fh_=__uint_as_float(ph_<<16); \
    const unsigned pl_=cvtpk_s(tgt_-fh_,0.f)&0xffffu; const float mnew_=fh_+__uint_as_float(pl_<<16); DLE=mnew_-mhat; mhat=mnew_; \
    qx1=hi?0u:(0x3F80u|(ph_<<16)); qx2=hi?0u:pl_; }while(0)
  const int qrel=wid*QBLK+r32;
  #define CMASK(P0,P1,t) do{ if((t)<4)cmask(P0,P1,(t),qrel,hi); }while(0)
  bool resc=false;
  #define START(P0,P1) do{ const float rm=rowmax(P0,P1); resc=false; \
    { float dl; SETREF(rm,dl); \
      _Pragma("unroll") for(int r=0;r<16;++r){P0[r]=fsub_s(P0[r],dl);P1[r]=fsub_s(P1[r],dl);} } \
    _Pragma("unroll") for(int r=0;r<16;++r)P0[r]=__builtin_amdgcn_exp2f(P0[r]); }while(0)
  #define RESC() do{ if(resc){ asm volatile("s_waitcnt lgkmcnt(0)":::"memory"); \
      _Pragma("unroll") for(int d_=0;d_<2;++d_) _Pragma("unroll") for(int r=0;r<16;++r)o[d_][r]*=wsf[crow(r,hi)]; } }while(0)
  f32x16 pA0,pA1,pB0,pB1;
  int sl_prev=0,sl_cur=0,sl_next=SLOTB;
  #define ROT() do{sl_prev=sl_cur;sl_cur=sl_next;sl_next=(sl_next==(NSLOT-1)*SLOTB)?0:sl_next+SLOTB;}while(0)
  DMA_K(2,2*SLOTB);
  WAIT_BAR(3);
  qkt(pA0,pA1,Kbase,shm+LDS_KX,qr,QXF,r32,hi);asm volatile("s_nop 15\n\ts_nop 7":"+v"(pA0),"+v"(pA1));CMASK(pA0,pA1,0);
  START(pA0,pA1);
  _Pragma("unroll") for(int r=0;r<16;++r)pA1[r]=__builtin_amdgcn_exp2f(pA1[r]);
  WAIT_BAR(0);
  DMA_KX(3,0);DMA_K(3,0);DMA_V(1,SLOTB);
  ROT();
  kload8(kf,kp0+sl_cur); kxw0=*(const __attribute__((address_space(3))) u32x2_t*)(kxp0+(sl_cur>>3)); kxw1=*(const __attribute__((address_space(3))) u32x2_t*)(kxp0+(sl_cur>>3)+256);
  WAIT_BAR(2);
  s16x4 vlo[8],vhi[8]; u32x4 pw0,pw1,pw2,pw3;
  #define PKW(P,B) cvtpk_s(P[B],P[B+1])
  #define PAF(k) __builtin_bit_cast(bf16x8,pw##k)
  #define VFR(i) (bf16x8){vlo[i][0],vlo[i][1],vlo[i][2],vlo[i][3],vhi[i][0],vhi[i][1],vhi[i][2],vhi[i][3]}
  #define PIN(x) asm volatile("":"+v"(x))
  #define MX3(a,b,c) __builtin_fmaxf(__builtin_fmaxf((a),(b)),(c))
  #define GAPA(MF,A0,A1,A2,A3,W0,W1,PW) do{ MF; sacc+=A0; sacc+=A1; sacc+=A2; sacc+=A3; PIN(sacc); W0; W1; PIN(PW); SBAR(); }while(0)
  #define EX(v) __builtin_amdgcn_exp2f(v)
  #define GAPB(MF,X,B) do{ MF; X[B]=EX(X[B]); X[B+1]=EX(X[B+1]); X[B+2]=EX(X[B+2]); X[B+3]=EX(X[B+3]); PIN(X); SBAR(); }while(0)
  #define VRD(i) do{ vlo[i]=vtr(vp_+(((i)>>2)*4096+((i)&3)*1024)); vhi[i]=vtr(vp_+(((i)>>2)*4096+((i)&3)*1024+512)); }while(0)
  #define KRD(G,j) do{ if(G){ kload2(kf,kp0+sl_next,j); SBAR(); } }while(0)
  #define KXRD(G) do{ if(G){ kxw0=*(const __attribute__((address_space(3))) u32x2_t*)(kxp0+(sl_next>>3)); kxw1=*(const __attribute__((address_space(3))) u32x2_t*)(kxp0+(sl_next>>3)+256); SBAR(); } }while(0)
  #define STEP(C0,C1,P0,P1,t,GK,GV,GL) do{ SBAR(); \
    const lds_cptr vp_=vp0+sl_prev; const f32x16 z16_=f32x16{}; const bf16x8 qxf_=QXF; \
    VRD(0); SBAR(); float sacc=(P0[0]+P0[1]); \
    GAPA(C0=__builtin_amdgcn_mfma_f32_32x32x16_bf16(kf[0],qr[0],z16_,0,0,0), P0[2],P0[3],P0[4],P0[5],     pw0[0]=PKW(P0,0), pw0[1]=PKW(P0,2), pw0); \
    VRD(4); SBAR(); GAPA(C1=__builtin_amdgcn_mfma_f32_32x32x16_bf16(kf[1],qr[0],z16_,0,0,0), P0[6],P0[7],P0[8],P0[9],     pw0[2]=PKW(P0,4), pw0[3]=PKW(P0,6), pw0); \
    VRD(1); SBAR(); GAPA(C0=__builtin_amdgcn_mfma_f32_32x32x16_bf16(kf[2],qr[1],C0,0,0,0),   P0[10],P0[11],P0[12],P0[13], pw1[0]=PKW(P0,8), pw1[1]=PKW(P0,10), pw1); \
    VRD(5); SBAR(); GAPA(C1=__builtin_amdgcn_mfma_f32_32x32x16_bf16(kf[3],qr[1],C1,0,0,0),   P0[14],P0[15],P1[0],P1[1],   pw1[2]=PKW(P0,12),pw1[3]=PKW(P0,14), pw1); \
    VRD(2); SBAR(); GAPA(C0=__builtin_amdgcn_mfma_f32_32x32x16_bf16(kf[4],qr[2],C0,0,0,0),   P1[2],P1[3],P1[4],P1[5],     pw2[0]=PKW(P1,0), pw2[1]=PKW(P1,2), pw2); \
    VRD(6); SBAR(); GAPA(C1=__builtin_amdgcn_mfma_f32_32x32x16_bf16(kf[5],qr[2],C1,0,0,0),   P1[6],P1[7],P1[8],P1[9],     pw2[2]=PKW(P1,4), pw2[3]=PKW(P1,6), pw2); \
    VRD(3); SBAR(); GAPA(C0=__builtin_amdgcn_mfma_f32_32x32x16_bf16(kf[6],qr[3],C0,0,0,0),   P1[10],P1[11],P1[12],P1[13], pw3[0]=PKW(P1,8), pw3[1]=PKW(P1,10), pw3); \
    VRD(7); SBAR(); GAPA(C1=__builtin_amdgcn_mfma_f32_32x32x16_bf16(kf[7],qr[3],C1,0,0,0),   P1[14],P1[15],0.f,0.f,       pw3[2]=PKW(P1,12),pw3[3]=PKW(P1,14), pw3); \
    C0=__builtin_amdgcn_mfma_f32_32x32x16_bf16(KXFRAG(kxw0),qxf_,C0,0,0,0); SBAR(); C1=__builtin_amdgcn_mfma_f32_32x32x16_bf16(KXFRAG(kxw1),qxf_,C1,0,0,0); SBAR(); \
    l_reg+=sacc; \
    if(GK){DMA_KX((t)+3,sl_cur);DMA_K((t)+3,sl_cur);} if(GV){DMA_V((t)+1,sl_next);} \
    CMASK(C0,C1,t); \
    { float a=MX3(C0[0],C0[1],C1[0]),b=MX3(C0[2],C0[3],C1[1]); a=MX3(a,C1[2],C1[3]); \
      _Pragma("unroll") for(int r=4;r<16;r+=4){a=MX3(a,C0[r],C0[r+1]);b=MX3(b,C0[r+2],C0[r+3]);a=MX3(a,C1[r],C1[r+1]);b=MX3(b,C1[r+2],C1[r+3]);} \
      float rm=__builtin_fmaxf(a,b); { auto rr=__builtin_amdgcn_permlane32_swap(__float_as_uint(rm),__float_as_uint(rm),false,false); rm=__builtin_fmaxf(__uint_as_float(rr[0]),__uint_as_float(rr[1])); } \
      resc=false; \
      if(__builtin_expect(__any(rm>(float)THRL),0)){ float dl; SETREF(__builtin_fmaxf(rm,0.f),dl); \
        _Pragma("unroll") for(int r=0;r<16;++r){C0[r]-=dl;C1[r]-=dl;} \
        const float f=__builtin_amdgcn_exp2f(-dl); l_reg*=f; if(hi==0)wsf[r32]=f; resc=true; } } \
    SBAR(); \
    GAPB(o[0]=__builtin_amdgcn_mfma_f32_32x32x16_bf16(PAF(0),VFR(0),o[0],0,0,0), C0,0); \
    GAPB(o[1]=__builtin_amdgcn_mfma_f32_32x32x16_bf16(PAF(0),VFR(4),o[1],0,0,0), C0,4); \
    KXRD(GL); KRD(GL,0); GAPB(o[0]=__builtin_amdgcn_mfma_f32_32x32x16_bf16(PAF(1),VFR(1),o[0],0,0,0), C0,8); \
    KRD(GL,1); GAPB(o[1]=__builtin_amdgcn_mfma_f32_32x32x16_bf16(PAF(1),VFR(5),o[1],0,0,0), C0,12); \
    KRD(GL,2); GAPB(o[0]=__builtin_amdgcn_mfma_f32_32x32x16_bf16(PAF(2),VFR(2),o[0],0,0,0), C1,0); \
    KRD(GL,3); GAPB(o[1]=__builtin_amdgcn_mfma_f32_32x32x16_bf16(PAF(2),VFR(6),o[1],0,0,0), C1,4); \
    GAPB(o[0]=__builtin_amdgcn_mfma_f32_32x32x16_bf16(PAF(3),VFR(3),o[0],0,0,0), C1,8); \
    GAPB(o[1]=__builtin_amdgcn_mfma_f32_32x32x16_bf16(PAF(3),VFR(7),o[1],0,0,0), C1,12); \
    }while(0)
  int t=1;
  #define ENDW(tt) do{ if((tt)+3<NTE){WAIT_BAR(2);} else if((tt)+2<NTE){WAIT_BAR(1);} else {WAIT_BAR(0);} }while(0)
  for(;t+1<NTE;t+=2){
    if(t>=5){
      #undef CMASK
      #define CMASK(P0,P1,t) do{}while(0)
      for(;t+5<NTE;t+=2){
        STEP(pB0,pB1,pA0,pA1,t,true,true,true);     WAIT_BAR(2); RESC(); ROT();
        STEP(pA0,pA1,pB0,pB1,t+1,true,true,true);   WAIT_BAR(2); RESC(); ROT();
      }
      #undef CMASK
      #define CMASK(P0,P1,t) do{ if((t)<4)cmask(P0,P1,(t),qrel,hi); }while(0)
      if(!(t+1<NTE))break;
    }
    STEP(pB0,pB1,pA0,pA1,t,(t+3<NTE),(t+1<NTE),(t+1<NTE));       ENDW(t);   RESC(); ROT();
    STEP(pA0,pA1,pB0,pB1,t+1,(t+4<NTE),(t+2<NTE),(t+2<NTE));     ENDW(t+1); RESC(); ROT();
  }
  STEP(pB0,pB1,pA0,pA1,NTE-1,false,false,false); RESC();
  { float sacc=pB0[0]+pB0[1]; _Pragma("unroll") for(int r=2;r<16;++r)sacc+=pB0[r]; _Pragma("unroll") for(int r=0;r<16;++r)sacc+=pB1[r]; l_reg+=sacc;
    pw0=(u32x4){PKW(pB0,0),PKW(pB0,2),PKW(pB0,4),PKW(pB0,6)};pw1=(u32x4){PKW(pB0,8),PKW(pB0,10),PKW(pB0,12),PKW(pB0,14)};pw2=(u32x4){PKW(pB1,0),PKW(pB1,2),PKW(pB1,4),PKW(pB1,6)};pw3=(u32x4){PKW(pB1,8),PKW(pB1,10),PKW(pB1,12),PKW(pB1,14)};
    SBAR(); pv(o,vb0+sl_cur,PAF(0),PAF(1),PAF(2),PAF(3)); }
  #undef PKW
  #undef PAF
  #undef VFR
  #undef PIN
  #undef MX3
  #undef GAPA
  #undef GAPB
  #undef EX
  #undef VRD
  #undef KRD
  #undef KXRD
  #undef STEP
  #undef ENDW
  {auto rr=__builtin_amdgcn_permlane32_swap(__float_as_uint(l_reg),__float_as_uint(l_reg),false,false);l_reg=__uint_as_float(rr[0])+__uint_as_float(rr[1]);}
  if(hi==0)wsf[32+r32]=l_reg;asm volatile("s_waitcnt lgkmcnt(0)":::"memory");
  float rli[16];
  #pragma unroll
  for(int r=0;r<16;++r)rli[r]=__builtin_amdgcn_rcpf(wsf[32+crow(r,hi)]);
  bf16*Ow=O+(rowbase+q0+wid*QBLK)*DM+h*D;
  { bf16*stg=(bf16*)(shm+LDS_OST)+wid*2048;
    #pragma unroll
    for(int r=0;r<16;++r){const int orow=crow(r,hi);
      #pragma unroll
      for(int d0=0;d0<2;++d0)stg[orow*64+d0*32+r32]=__float2bfloat16(o[d0][r]*rli[r]);}
    asm volatile("s_waitcnt lgkmcnt(0)":::"memory");
    #pragma unroll
    for(int i=0;i<4;++i){const int row=i*8+(lane>>3),ch=lane&7; const u32x4 v=*(const u32x4*)(stg+row*64+ch*8); ATTN_STORE16(Ow+(long)row*DM+ch*8,v);} }
  asm volatile("s_waitcnt lgkmcnt(0)\n\ts_barrier":::"memory");
  #undef DMA_K
  #undef DMA_V
  #undef DMA_KX
  #undef TILE
  #undef QXF
  #undef SETREF
  #undef CMASK
  #undef START
  #undef RESC
  #undef ROT
}
constexpr int ATTN_LDS_BYTES=LDS_BYTES;
struct AttnTensors { const bf16* Q; const bf16* K; const bf16* V; const unsigned* KX; bf16* O; };
struct AttnUnit { int bh; int qb; };
struct AttnQueue { unsigned* ctr; const float* BIAS; const float* NORM; int nunits; };
template<int THRL=8> __device__ __forceinline__ void attn_phase(char*lds,volatile __attribute__((address_space(3))) unsigned* bc,const AttnTensors&T,const AttnQueue&Qu){
  const int lane=threadIdx.x&63;
  for(;;){
    if(threadIdx.x==0) bc[0]=__hip_atomic_fetch_add(Qu.ctr,1u,__ATOMIC_RELAXED,__HIP_MEMORY_SCOPE_AGENT);
    __syncthreads();
    const int u=(int)bc[0];
    if(u>=Qu.nunits)break;
    const int uu=u&511, bh=uu&15, qb=31-(uu>>4), NT=4*qb+4;
    const float pq=Qu.NORM[bh*2], pk=Qu.NORM[bh*2+1];
    const float thr=153.f+4.08f*sqrtf(pq*pk);
    const float* B=Qu.BIAS+(long)bh*SEQ; const float b0=B[qb*QB];
    const bool n0=(lane<NT)&&!(b0-B[64*lane+63]>thr), n1=(lane+64<NT)&&!(b0-B[64*(lane+64)+63]>thr);
    const unsigned long long m0=__ballot(n0), m1=__ballot(n1);
    int alo=m0?(int)__builtin_ctzll(m0):(m1?64+(int)__builtin_ctzll(m1):NT);
    if(alo>NT-4)alo=NT-4;
    int nx=NT-4-alo; nx+=nx&1;
    attn_unit<THRL>(bh/NHEAD,bh%NHEAD,qb,4+nx,T.Q,T.K,T.V,T.KX,T.O,lds);
  }
}
#undef SBAR
#undef WAIT_BAR
}
constexpr int NWAVES = 8;
#ifndef MK_N_LAUNCHES
#define MK_N_LAUNCHES 1
#endif
constexpr int NPH = 11;
constexpr int BATCH = 2, SEQ = 8192, D = 1024, T = BATCH * SEQ, NH = 8, HD = 64, AW = 512, CW = 512, CK = 31, NE = 32, TOPK = 4, DE = 1024, NMOD = 6, INC = 4616, NIN = 4608, OFF_F = 2560;
constexpr int SLOTS_MAX = T * TOPK + NE * 256, TILES_MAX = SLOTS_MAX / 256;
constexpr float RMS_EPS = 1e-5f, LN_EPS = 1e-5f, LOG2E = 1.4426950408889634f;
constexpr size_t MiB = 1u << 20;
constexpr size_t WS_CTL = 0, CTL_ZERO_BYTES = 64 * 1024;
constexpr size_t WS_MOD = 1 * MiB;
constexpr size_t WS_LF = WS_MOD + 256 * 1024;
constexpr size_t WS_KX = 2 * MiB;
constexpr size_t WS_WRT = 5 * MiB + 512 * 1024;
constexpr size_t WS_BIAS = 5 * MiB;
constexpr size_t CTL_NORM = 40960, CTL_QCTR = 40960 + 256, CTL_CVT = 40960 + 512, CTL_DONE = 40960 + 1024;
constexpr size_t WS_HIST = 3 * MiB;
constexpr size_t WS_TOPE = WS_HIST + 256 * 1024, WS_TOPG = WS_TOPE + 256 * 1024, WS_LRANK = WS_TOPG + 256 * 1024;
constexpr size_t WS_SLOT_TOK = 4 * MiB, WS_TOK_SLOT = WS_SLOT_TOK + 512 * 1024, WS_TILE_E = WS_TOK_SLOT + 256 * 1024;
constexpr size_t WS_WIN = 6 * MiB;
constexpr size_t WS_WC = 15 * MiB, WS_WA = 16 * MiB, WS_WO = 17 * MiB;
constexpr size_t WS_W1 = 20 * MiB;
constexpr size_t WS_W2 = 148 * MiB;
constexpr size_t WS_H = 212 * MiB;
constexpr size_t WS_AGLU = 244 * MiB, WS_Q = 260 * MiB, WS_K = 276 * MiB, WS_V = 292 * MiB;
constexpr size_t WS_SGC = 308 * MiB, WS_SGA = 340 * MiB;
constexpr size_t WS_ALN = 372 * MiB, WS_ATT = 388 * MiB;
constexpr size_t WS_MIX = 404 * MiB;
constexpr size_t WS_X1 = 436 * MiB;
constexpr size_t WS_HM = 500 * MiB;
constexpr size_t WS_YB = 644 * MiB;
constexpr size_t WS_END = 788 * MiB;
constexpr int CW_BAR = 1024;
constexpr int RING_BYTES = 131072;
constexpr int LDSCTL_OFF = RING_BYTES, MISC_OFF = LDSCTL_OFF + 320;
constexpr int ROWTAB_OFF = RING_BYTES + 1024, ROWTAB_UNITS = 12;
constexpr int LDS_BYTES = 147456;
static_assert(ROWTAB_OFF + ROWTAB_UNITS * 1024 <= LDS_BYTES, "LDS map");

#define GAS __attribute__((address_space(1)))
#define LAS __attribute__((address_space(3)))
typedef unsigned short bf16;
typedef unsigned v4u __attribute__((ext_vector_type(4)));
typedef unsigned v2u __attribute__((ext_vector_type(2)));
typedef float f32x4 __attribute__((ext_vector_type(4)));
typedef GAS unsigned gu32;
#define RLX_AGENT __ATOMIC_RELAXED, __HIP_MEMORY_SCOPE_AGENT
#define LDS_WAIT() asm volatile("s_waitcnt lgkmcnt(0)" ::: "memory")
#define VM_WAIT() asm volatile("s_waitcnt vmcnt(0)" ::: "memory")
__device__ __forceinline__ unsigned pk2(float lo, float hi) { return pg8::cvt_pk_bf16(lo, hi); }
__device__ __forceinline__ int fresh_lane() { int l; asm volatile("v_mbcnt_lo_u32_b32 %0, -1, 0\n\tv_mbcnt_hi_u32_b32 %0, -1, %0" : "=v"(l)); return l; }
__device__ __forceinline__ float wave_sum(float v) {
    v += __builtin_bit_cast(float, __builtin_amdgcn_update_dpp(0, __builtin_bit_cast(int, v), 0xB1, 0xF, 0xF, false));
    v += __builtin_bit_cast(float, __builtin_amdgcn_update_dpp(0, __builtin_bit_cast(int, v), 0x4E, 0xF, 0xF, false));
    v += __builtin_bit_cast(float, __builtin_amdgcn_update_dpp(0, __builtin_bit_cast(int, v), 0x141, 0xF, 0xF, false));
    v += __builtin_bit_cast(float, __builtin_amdgcn_update_dpp(0, __builtin_bit_cast(int, v), 0x140, 0xF, 0xF, false));
    v += __builtin_bit_cast(float, __builtin_amdgcn_update_dpp(0, __builtin_bit_cast(int, v), 0x142, 0xA, 0xF, false));
    v += __builtin_bit_cast(float, __builtin_amdgcn_update_dpp(0, __builtin_bit_cast(int, v), 0x143, 0xC, 0xF, false));
    return __builtin_bit_cast(float, __builtin_amdgcn_readlane(__builtin_bit_cast(int, v), 63));
}

#define XB_TMO      128
#define XB_XCNT(j)  (256  + 64 * (j))
#define XB_XSUB(j)  (1280 + 64 * (j))
#define XB_XGEN(j)  (2304 + 64 * (j))
#define XB_TOP      3328
#define XB_TOPGEN   3392
#define XCD_BAR_WORDS 3456
#define XB_SPIN_CAP (1u << 18)
__device__ __forceinline__ unsigned xb_ld(unsigned* p)              { return __hip_atomic_load(p, __ATOMIC_RELAXED, __HIP_MEMORY_SCOPE_AGENT); }
__device__ __forceinline__ unsigned xb_add(unsigned* p, unsigned v) { return __hip_atomic_fetch_add(p, v, __ATOMIC_RELAXED, __HIP_MEMORY_SCOPE_AGENT); }
__device__ __forceinline__ unsigned xb_xcc_id() { return (unsigned)__builtin_amdgcn_s_getreg((3 << 11) | 20) & 0xFu; }
#define XB_SPIN(cond, bar) do { unsigned _sp = 0; while (cond) { __builtin_amdgcn_s_sleep(1); \
    if ((++_sp & 255u) == 0u) { if (xb_ld(&(bar)[XB_TMO])) break; if (_sp > XB_SPIN_CAP) { atomicAdd(&(bar)[XB_TMO], 1u); break; } } } } while (0)
struct XcdBarrier { unsigned* bar; unsigned x; volatile LAS unsigned* st; };
__device__ __forceinline__ XcdBarrier xcd_barrier_post(unsigned* bar, volatile LAS unsigned* st) {
    XcdBarrier b; b.bar = bar; b.x = xb_xcc_id(); b.st = st;
    if (threadIdx.x == 0) (void)xb_add(&bar[XB_XCNT(b.x)], 1u);
    return b;
}
__device__ __forceinline__ void xcd_barrier_complete(unsigned* bar, unsigned x, unsigned& nloc, unsigned& nx) {
    const unsigned G = gridDim.x * gridDim.y * gridDim.z;
    unsigned sum, cnt, mine, sp = 0u;
    for (;;) {
        sum = 0u; cnt = 0u; mine = 0u;
#pragma unroll
        for (unsigned j = 0; j < 16; ++j) { const unsigned c = xb_ld(&bar[XB_XCNT(j)]); sum += c; cnt += (c > 0u) ? 1u : 0u; mine = (j == x) ? c : mine; }
        if (sum == G) break;
        __builtin_amdgcn_s_sleep(1);
        if ((++sp & 255u) == 0u) { if (xb_ld(&bar[XB_TMO])) break; if (sp > XB_SPIN_CAP) { atomicAdd(&bar[XB_TMO], 1u); break; } }
    }
    nloc = mine > 0u ? mine : 1u; nx = cnt > 0u ? cnt : 1u;
}
__device__ __forceinline__ void xcd_barrier(const XcdBarrier& b) {
    asm volatile("s_waitcnt vmcnt(0)" ::: "memory");
    __syncthreads();
    if (threadIdx.x == 0) {
        unsigned* bar = b.bar;
        __builtin_amdgcn_s_waitcnt(0);
        unsigned nloc = b.st[0], nx = b.st[1];
        if (nloc == 0u) { xcd_barrier_complete(bar, b.x, nloc, nx); b.st[0] = nloc; b.st[1] = nx; }
        const unsigned old = xb_add(&bar[XB_XSUB(b.x)], 1u);
        const unsigned gen = old / nloc;
        if (old + 1u == (gen + 1u) * nloc) {
            __builtin_amdgcn_fence(__ATOMIC_RELEASE, "agent");
            asm volatile("s_waitcnt vmcnt(0)" ::: "memory");
            const unsigned og = xb_add(&bar[XB_TOP], 1u);
            const unsigned tg = og / nx;
            if (og + 1u == (tg + 1u) * nx) xb_add(&bar[XB_TOPGEN], 1u);
            else XB_SPIN(xb_ld(&bar[XB_TOPGEN]) == tg, bar);
            __builtin_amdgcn_fence(__ATOMIC_ACQUIRE, "agent");
            xb_add(&bar[XB_XGEN(b.x)], 1u);
            asm volatile("s_waitcnt vmcnt(0)" ::: "memory");
        } else {
            XB_SPIN(xb_ld(&bar[XB_XGEN(b.x)]) == gen, bar);
            __builtin_amdgcn_fence(__ATOMIC_ACQUIRE, "agent");
            asm volatile("s_waitcnt vmcnt(0)" ::: "memory");
        }
    }
    __syncthreads();
}

struct Args { const float* in[22]; float* out; unsigned char* ws; int ph_lo, ph_hi; };

struct Frame {
    LAS unsigned char* lds; int tid, lane, wave, vcu, G; unsigned char* ws;
};

__device__ __forceinline__ void p0_mod(Frame& F, const float* c, const float* w_ada, const float* b_ada, float* mod) {
    LAS float* sc = (LAS float*)F.lds;
    LAS float* red = sc + 2048;
    for (int i = F.tid; i < 2048; i += NWAVES * 64) { const float v = c[i]; sc[i] = v * pg8::sigm(v); }
    __syncthreads();
    for (int item = F.vcu; item < (NMOD * D) / 24; item += F.G) {
        const int n0 = item * 24, col = F.tid % 24, kp = F.tid / 24;
        if (kp < 21) {
            float a0 = 0.f, a1 = 0.f;
#pragma unroll 7
            for (int k = kp; k < D; k += 21) { const float w = w_ada[(size_t)k * (NMOD * D) + n0 + col]; a0 += sc[k] * w; a1 += sc[1024 + k] * w; }
            red[kp * 24 + col] = a0; red[504 + kp * 24 + col] = a1;
        }
        __syncthreads();
        if (F.tid < 48) { const int b = F.tid / 24, cc = F.tid % 24; float s = 0.f;
            for (int j = 0; j < 21; ++j) s += red[b * 504 + j * 24 + cc];
            mod[b * (NMOD * D) + n0 + cc] = s + b_ada[n0 + cc]; }
        __syncthreads();
    }
}
__device__ __forceinline__ void tr_item(const float* W, int ldw, int col0, int k0, bf16* WT, int Kd, int drow0, LAS float* scr, int lane) {
    float v[32];
#pragma unroll
    for (int i = 0; i < 32; ++i) { const int kk = 2 * i + (lane >> 5); v[i] = W[(size_t)(k0 + kk) * ldw + col0 + (lane & 31)]; }
#pragma unroll
    for (int i = 0; i < 32; ++i) { const int kk = 2 * i + (lane >> 5); scr[kk * 33 + (lane & 31)] = v[i]; }
    LDS_WAIT(); asm volatile("" ::: "memory");
    const int c = lane & 7;
#pragma unroll
    for (int j = 0; j < 4; ++j) { const int n = (lane >> 3) + 8 * j; const LAS float* s = scr + (8 * c) * 33 + n;
        v4u o; o.x = pk2(s[0 * 33], s[1 * 33]); o.y = pk2(s[2 * 33], s[3 * 33]); o.z = pk2(s[4 * 33], s[5 * 33]); o.w = pk2(s[6 * 33], s[7 * 33]);
        *(GAS v4u*)(WT + (size_t)(drow0 + n) * Kd + k0 + 8 * c) = o; }
    LDS_WAIT(); asm volatile("" ::: "memory");
}
__device__ __forceinline__ void tr_item8(const float* W, int ldw, int col0, int k0, unsigned char* WT, int Kd, int drow0, LAS float* scr, int lane) {
    float v[32];
#pragma unroll
    for (int i = 0; i < 32; ++i) { const int kk = 2 * i + (lane >> 5); v[i] = __builtin_nontemporal_load(W + (size_t)(k0 + kk) * ldw + col0 + (lane & 31));   }
#pragma unroll
    for (int i = 0; i < 32; ++i) { const int kk = 2 * i + (lane >> 5); scr[kk * 33 + (lane & 31)] = v[i] * 32.f; }
    LDS_WAIT(); asm volatile("" ::: "memory");
    const int n = lane & 31, kh = lane >> 5; const LAS float* sp = scr + (32 * kh) * 33 + n;
    v4u o0, o1;
    o0.x = pg8::pk4_fp8(sp[0 * 33], sp[1 * 33], sp[2 * 33], sp[3 * 33]);     o0.y = pg8::pk4_fp8(sp[4 * 33], sp[5 * 33], sp[6 * 33], sp[7 * 33]);
    o0.z = pg8::pk4_fp8(sp[8 * 33], sp[9 * 33], sp[10 * 33], sp[11 * 33]);   o0.w = pg8::pk4_fp8(sp[12 * 33], sp[13 * 33], sp[14 * 33], sp[15 * 33]);
    o1.x = pg8::pk4_fp8(sp[16 * 33], sp[17 * 33], sp[18 * 33], sp[19 * 33]); o1.y = pg8::pk4_fp8(sp[20 * 33], sp[21 * 33], sp[22 * 33], sp[23 * 33]);
    o1.z = pg8::pk4_fp8(sp[24 * 33], sp[25 * 33], sp[26 * 33], sp[27 * 33]); o1.w = pg8::pk4_fp8(sp[28 * 33], sp[29 * 33], sp[30 * 33], sp[31 * 33]);
    GAS v4u* dst = (GAS v4u*)(WT + (size_t)(drow0 + n) * Kd + k0 + 32 * kh);
    dst[0] = o0; dst[1] = o1;
    LDS_WAIT(); asm volatile("" ::: "memory");
}
__device__ __forceinline__ void p0_router_w(Frame& F, const float* w_router) {
    bf16* WRT = (bf16*)(F.ws + WS_WRT);
    for (int i = F.vcu * NWAVES * 64 + F.tid; i < NE * D; i += F.G * NWAVES * 64) { const int e = i >> 10, k = i & 1023; const float w = w_router[(size_t)k * NE + e];
        const unsigned h = pk2(w, 0.f) & 0xffffu; const float fh = __builtin_bit_cast(float, h << 16); const unsigned lo = pk2(w - fh, 0.f) & 0xffffu;
        WRT[i] = (bf16)h; WRT[NE * D + i] = (bf16)lo; }
}
__device__ __forceinline__ void p0_convert(Frame& F, const float* w_in, const float* w_conv_out, const float* w_attn_out, const float* w_out, const float* w_exp_in, const float* w_exp_out) {
    LAS float* scr = (LAS float*)(F.lds + 16384 + F.wave * 12288);
    bf16* WIN = (bf16*)(F.ws + WS_WIN); bf16* WC = (bf16*)(F.ws + WS_WC); bf16* WA = (bf16*)(F.ws + WS_WA); bf16* WO = (bf16*)(F.ws + WS_WO); bf16* W1 = (bf16*)(F.ws + WS_W1); bf16* W2 = (bf16*)(F.ws + WS_W2);
    const int gw = F.vcu * NWAVES + F.wave, NGW = F.G * NWAVES;
    constexpr int I_IN = 16 * 144, I_C = 8 * 32, I_O = 16 * 32;
    constexpr int NITEMS = I_IN + 2 * I_C + I_O;
    for (int it = gw; it < NITEMS; it += NGW) {
        int r = it;
        if (r < I_IN) { const int kb = r / 144, db = r % 144; int src;
            if (db < 32) { const int tile = db >> 3, w = db & 7; src = (w < 4) ? 128 * tile + 32 * w : 512 + 128 * tile + 32 * (w - 4); }
            else if (db < 80) src = 32 * db; else src = 32 * db + 8;
            tr_item8(w_in, INC, src, 64 * kb, (unsigned char*)WIN, D, 32 * db, scr, F.lane); continue; } r -= I_IN;
        if (r < I_C) { tr_item(w_conv_out, D, 32 * (r % 32), 64 * (r / 32), WC, CW, 32 * (r % 32), scr, F.lane); continue; } r -= I_C;
        if (r < I_C) { tr_item(w_attn_out, D, 32 * (r % 32), 64 * (r / 32), WA, AW, 32 * (r % 32), scr, F.lane); continue; } r -= I_C;
        tr_item(w_out, D, 32 * (r % 32), 64 * (r / 32), WO, D, 32 * (r % 32), scr, F.lane);
    }
}
#ifndef CVT_FILL_WAVES
#define CVT_FILL_WAVES 8
#endif
constexpr int CVT_I1 = 16 * 64 * NE, CVT_I2 = 16 * 32 * NE, CVT_ITEMS = CVT_I1 + CVT_I2;
__device__ __forceinline__ void cvt_one(Frame& F, const float* w_exp_in, const float* w_exp_out, int r, LAS float* scr, int lane) {
    unsigned char* W1 = (unsigned char*)(F.ws + WS_W1); unsigned char* W2 = (unsigned char*)(F.ws + WS_W2);
    if (r < CVT_I1) { const int e = r / 1024, qq = r % 1024, kb = qq % 16, db = qq / 16, tile = db >> 3, w = db & 7; const int src = (w < 4) ? 128 * tile + 32 * w : 1024 + 128 * tile + 32 * (w - 4);
        tr_item8(w_exp_in + (size_t)e * D * 2 * DE, 2 * DE, src, 64 * kb, W1 + (size_t)e * 2 * DE * D, D, 32 * db, scr, lane); }
    else { r -= CVT_I1; const int e = r / 512, qq = r % 512, kb = qq % 16, nb = qq / 16;
        tr_item8(w_exp_out + (size_t)e * DE * D, D, 32 * nb, 64 * kb, W2 + (size_t)e * D * DE, DE, 32 * nb, scr, lane); }
}
constexpr int CVT_CHUNK = 16;
__device__ __forceinline__ int cvt_claim(volatile LAS unsigned* misc, gu32* ctr, int lane) {
    for (;;) {
        const unsigned w = misc[10];
        if (w == 0xFFFFFFFFu) return -1;
        const unsigned used = w & 63u;
        if (w != 0u && used < (unsigned)CVT_CHUNK) {
            unsigned seen = w;
            if (lane == 0) { unsigned exp = w; (void)__hip_atomic_compare_exchange_strong((LAS unsigned*)(misc + 10), &exp, w + 1u, __ATOMIC_RELAXED, __ATOMIC_RELAXED, __HIP_MEMORY_SCOPE_WORKGROUP); seen = exp; }
            seen = (unsigned)__builtin_amdgcn_readfirstlane((int)seen);
            if (seen == w) return (int)((w >> 6) - 1u + used);
            continue;
        }
        unsigned lk = 1u;
        if (lane == 0) { unsigned exp = 0u; (void)__hip_atomic_compare_exchange_strong((LAS unsigned*)(misc + 11), &exp, 1u, __ATOMIC_RELAXED, __ATOMIC_RELAXED, __HIP_MEMORY_SCOPE_WORKGROUP); lk = exp; }
        lk = (unsigned)__builtin_amdgcn_readfirstlane((int)lk);
        if (lk == 0u) {
            if (misc[10] == w) {
                unsigned it = 0; if (lane == 0) it = __hip_atomic_fetch_add(ctr, (unsigned)CVT_CHUNK, RLX_AGENT);
                it = (unsigned)__builtin_amdgcn_readfirstlane((int)it);
                misc[10] = (it >= (unsigned)CVT_ITEMS) ? 0xFFFFFFFFu : ((it + 1u) << 6);
            }
            LDS_WAIT(); misc[11] = 0u; LDS_WAIT();
        } else __builtin_amdgcn_s_sleep(2);
    }
}
__device__ __forceinline__ void cvt_fill(Frame& F, const float* w_exp_in, const float* w_exp_out, int phase_tag, volatile LAS unsigned* misc) {
    LAS float* scr = (LAS float*)(F.lds + F.wave * 12288);
    gu32* ctr = (gu32*)(F.ws + WS_CTL + CTL_CVT); gu32* done = (gu32*)(F.ws + WS_CTL + CTL_DONE) + 64 * phase_tag;
    const int lane = fresh_lane();
    if (phase_tag && F.wave >= CVT_FILL_WAVES) return;
    for (;;) {
        if (phase_tag) {
            if (F.wave == 0) { if ((unsigned)__builtin_amdgcn_readfirstlane((int)__hip_atomic_load(done, RLX_AGENT)) >= (unsigned)F.G) misc[2] = (unsigned)phase_tag; }
            if (misc[2] == (unsigned)phase_tag) break;
        }
        const int r = cvt_claim(misc, ctr, lane);
        if (r < 0) break;
        cvt_one(F, w_exp_in, w_exp_out, r, scr, lane);
    }
}
__device__ __forceinline__ void phase_main_done(Frame& F, int phase_tag) {
    if (F.tid == 0) (void)__hip_atomic_fetch_add((gu32*)(F.ws + WS_CTL + CTL_DONE) + 64 * phase_tag, 1u, RLX_AGENT);
}
__device__ __forceinline__ float log_sigmoid_f(float x) { return fminf(x, 0.f) - log1pf(expf(-fabsf(x))); }
__device__ __forceinline__ void p1_norm1(Frame& F, const float* x, const float* g, const float* mod, const float* w_in, const float* b_forget) {
    LAS f32x4* wf = (LAS f32x4*)F.lds;
    for (int i = F.tid; i < 2048; i += NWAVES * 64) { const int k = i >> 1, h4 = i & 1; const int j = k >> 8, l = (k & 255) >> 2, c = k & 3;
        wf[((j * 4 + c) * 2 + h4) * 64 + l] = *(const f32x4*)(w_in + (size_t)k * INC + OFF_F + 4 * h4); }
    __syncthreads();
    bf16* H = (bf16*)(F.ws + WS_H); float* LF = (float*)(F.ws + WS_LF);
    const int gw = F.vcu * NWAVES + F.wave, NGW = F.G * NWAVES, l = F.lane;
    const float bfl = b_forget[l & 7];
    constexpr int RPW = 8;
    for (int m0 = gw * RPW; m0 < T; m0 += NGW * RPW) {
        const int b = m0 / SEQ;
        const float* sh = mod + (size_t)b * NMOD * D; const float* sc = sh + D;
        f32x4 gs[4], s0[4];
#pragma unroll
        for (int j = 0; j < 4; ++j) { const int k0 = 256 * j + 4 * l; gs[j] = *(const f32x4*)(g + k0) * (*(const f32x4*)(sc + k0) + 1.f); s0[j] = *(const f32x4*)(sh + k0); }
        f32x4 nx[4];
#pragma unroll
        for (int j = 0; j < 4; ++j) nx[j] = __builtin_nontemporal_load((const f32x4*)(x + (size_t)m0 * D + 256 * j + 4 * l));
#pragma unroll 1
        for (int i = 0; i < RPW; ++i) {
            const int m = m0 + i, t = m % SEQ;
            f32x4 v[4]; float ss = 0.f;
#pragma unroll
            for (int j = 0; j < 4; ++j) { v[j] = nx[j]; ss += (v[j].x * v[j].x + v[j].y * v[j].y) + (v[j].z * v[j].z + v[j].w * v[j].w); }
            if (i + 1 < RPW) {
#pragma unroll
                for (int j = 0; j < 4; ++j) nx[j] = __builtin_nontemporal_load((const f32x4*)(x + (size_t)(m + 1) * D + 256 * j + 4 * l));
            }
            const float rstd = rsqrtf(wave_sum(ss) * (1.f / D) + RMS_EPS);
            float fl[8];
#pragma unroll
            for (int hh = 0; hh < 8; ++hh) fl[hh] = 0.f;
#pragma unroll
            for (int j = 0; j < 4; ++j) { f32x4 hv = v[j] * rstd * gs[j] + s0[j]; v[j] = hv;
#pragma unroll
                for (int c = 0; c < 4; ++c) { const f32x4 w0 = wf[((j * 4 + c) * 2 + 0) * 64 + l], w1 = wf[((j * 4 + c) * 2 + 1) * 64 + l]; const float hc = hv[c];
                    fl[0] += hc * w0.x; fl[1] += hc * w0.y; fl[2] += hc * w0.z; fl[3] += hc * w0.w; fl[4] += hc * w1.x; fl[5] += hc * w1.y; fl[6] += hc * w1.z; fl[7] += hc * w1.w; } }
            GAS unsigned* o4 = (GAS unsigned*)((unsigned char*)H + (size_t)m * D) + l;
#pragma unroll
            for (int j = 0; j < 4; ++j) o4[64 * j] = pg8::pk4_fp8(v[j].x, v[j].y, v[j].z, v[j].w);
            float mine = 0.f;
#pragma unroll
            for (int hh = 0; hh < 8; ++hh) { const float s = wave_sum(fl[hh]); mine = ((l & 7) == hh) ? s : mine; }
            const float ls = log_sigmoid_f(mine + bfl);
            if (l < 8) LF[(size_t)(b * NH + l) * SEQ + t] = ls;
        }
    }
    __syncthreads();
}
__device__ __forceinline__ void p2_fscan(Frame& F, int bh) {
    LAS double* part = (LAS double*)F.lds;
    const float* LF = (const float*)(F.ws + WS_LF) + (size_t)bh * SEQ; v2u* KX = (v2u*)(F.ws + WS_KX) + (size_t)bh * SEQ; float* BIAS = (float*)(F.ws + WS_BIAS) + (size_t)bh * SEQ;
    const int i = F.tid;
    double loc[16]; double run = 0.0;
#pragma unroll
    for (int q = 0; q < 4; ++q) { const f32x4 v = *(const f32x4*)(LF + i * 16 + 4 * q);
        run += (double)v.x; loc[4 * q] = run; run += (double)v.y; loc[4 * q + 1] = run; run += (double)v.z; loc[4 * q + 2] = run; run += (double)v.w; loc[4 * q + 3] = run; }
    part[i] = run; __syncthreads();
    for (int o = 1; o < 512; o <<= 1) { const double pv = (i >= o) ? part[i - o] : 0.0; __syncthreads(); part[i] += pv; __syncthreads(); }
    const double base = (i > 0) ? part[i - 1] : 0.0;
#pragma unroll
    for (int j = 0; j < 16; ++j) { const float bias = (float)(-(base + loc[j]) * 1.4426950408889634);
        const unsigned ph = pk2(bias, 0.f) & 0xffffu; const float fh = __builtin_bit_cast(float, ph << 16);
        const float r1 = bias - fh; const unsigned pm = pk2(r1, 0.f) & 0xffffu; const float fm = __builtin_bit_cast(float, pm << 16);
        const unsigned pl = pk2(r1 - fm, 0.f) & 0xffffu;
        v2u o; o.x = ph | (pm << 16); o.y = pl | 0xBF800000u; KX[i * 16 + j] = o; BIAS[i * 16 + j] = bias; }
    __syncthreads();
}
__device__ __forceinline__ f32x4 ld4bf(const bf16* p) { const v2u w = *(const v2u*)p; return (f32x4){pg8::bf_lo(w.x), pg8::bf_hi(w.x), pg8::bf_lo(w.y), pg8::bf_hi(w.y)}; }
__device__ __forceinline__ float dppf(float v, const int ctrl_tag) {
    const int x = __builtin_bit_cast(int, v);
    return __builtin_bit_cast(float, ctrl_tag == 0 ? __builtin_amdgcn_update_dpp(0, x, 0xB1, 0xF, 0xF, false) : ctrl_tag == 1 ? __builtin_amdgcn_update_dpp(0, x, 0x4E, 0xF, 0xF, false)
                                   : ctrl_tag == 2 ? __builtin_amdgcn_update_dpp(0, x, 0x141, 0xF, 0xF, false) : __builtin_amdgcn_update_dpp(0, x, 0x140, 0xF, 0xF, false));
}
__device__ __forceinline__ int dppi(int x, const int ctrl_tag) {
    return ctrl_tag == 0 ? __builtin_amdgcn_update_dpp(0, x, 0xB1, 0xF, 0xF, false) : ctrl_tag == 1 ? __builtin_amdgcn_update_dpp(0, x, 0x4E, 0xF, 0xF, false)
         : ctrl_tag == 2 ? __builtin_amdgcn_update_dpp(0, x, 0x141, 0xF, 0xF, false) : __builtin_amdgcn_update_dpp(0, x, 0x140, 0xF, 0xF, false);
}
template <int N, int SZ> __device__ __forceinline__ void tr_step(float (&v)[SZ], int l) {
    if constexpr (N == 32 || N == 16) {
        const bool up = (l & N) != 0;
#pragma unroll
        for (int i = 0; i < N; ++i) { const float a = v[i], bb = v[i + N]; const float mine = up ? bb : a, other = up ? a : bb; v[i] = mine + __shfl_xor(other, N); }
    } else {
        const bool up = (l & N) != 0; constexpr int tag = (N == 8) ? 3 : (N == 4) ? 2 : (N == 2) ? 1 : 0;
#pragma unroll
        for (int i = 0; i < N; ++i) { const float a = v[i], bb = v[i + N]; const float mine = up ? bb : a, other = up ? a : bb; v[i] = mine + dppf(other, tag); }
    }
}
__device__ __forceinline__ float dot2c(float acc, unsigned a, unsigned b) { asm("v_dot2c_f32_bf16 %0, %1, %2" : "+v"(acc) : "v"(a), "v"(b)); return acc; }
__device__ __forceinline__ void p3_conv(Frame& F, const float* conv_w, const float* conv_b, const float* ln_g, const float* ln_b, volatile LAS unsigned* misc, int nrep) {
    LAS float* part = (LAS float*)F.lds;
    LAS unsigned short* ain = (LAS unsigned short*)(F.lds + 4096);
    LAS unsigned short* aout = (LAS unsigned short*)(F.lds + 4096 + 62 * 1024);
    const bf16* AGLU = (const bf16*)(F.ws + WS_AGLU); bf16* ALN = (bf16*)(F.ws + WS_ALN);
    const int l = fresh_lane(), c = 64 * F.wave + l;
    unsigned wE[16], wO[16];
    { float w[31];
#pragma unroll
      for (int j = 0; j < CK; ++j) w[j] = conv_w[j * CW + c];
#pragma unroll
      for (int q = 0; q < 15; ++q) wE[q] = pk2(w[2 * q], w[2 * q + 1]);
      wE[15] = pk2(w[30], 0.f); wO[0] = pk2(0.f, w[0]);
#pragma unroll
      for (int q = 1; q < 16; ++q) wO[q] = pk2(w[2 * q - 1], w[2 * q]); }
    const float cb = conv_b[c], lg = ln_g[c], lb = ln_b[c];
    gu32* qc = (gu32*)(F.ws + WS_CTL + CTL_QCTR) + 1;
    for (;;) {
        __syncthreads();
        if (F.tid == 0) misc[1] = __hip_atomic_fetch_add(qc, 1u, RLX_AGENT);
        __syncthreads();
        const int it_ = (int)misc[1]; if (it_ >= nrep * (T / 32)) break;
        const int item = it_ % (T / 32);
        const int r0 = item * 32, tt0 = r0 % SEQ;
        for (int i = F.tid; i < 62 * 64; i += NWAVES * 64) { const int rr = i >> 6, cc = i & 63; v4u v = (v4u){0u, 0u, 0u, 0u};
            if (tt0 + rr - 30 >= 0) v = *(const v4u*)(AGLU + (size_t)(r0 + rr - 30) * CW + cc * 8);
            *(LAS v4u*)(ain + rr * 512 + cc * 8) = v; }
        __syncthreads();
        unsigned A[31];
#pragma unroll
        for (int p2 = 0; p2 < 31; ++p2) A[p2] = (unsigned)ain[(2 * p2) * 512 + c] | ((unsigned)ain[(2 * p2 + 1) * 512 + c] << 16);
        float y[32];
#pragma unroll
        for (int R2 = 0; R2 < 16; ++R2) { float e = cb, o = cb;
#pragma unroll
            for (int q = 0; q < 16; ++q) { e = dot2c(e, A[R2 + q], wE[q]); o = dot2c(o, A[R2 + q], wO[q]); }
            asm volatile("s_nop 4" : "+v"(e), "+v"(o));
            y[2 * R2] = e; y[2 * R2 + 1] = o; }
        float s1[32], s2[32];
#pragma unroll
        for (int r = 0; r < 32; ++r) { s1[r] = y[r]; s2[r] = y[r] * y[r]; }
        tr_step<16, 32>(s1, l); tr_step<8, 32>(s1, l); tr_step<4, 32>(s1, l); tr_step<2, 32>(s1, l); tr_step<1, 32>(s1, l);
        tr_step<16, 32>(s2, l); tr_step<8, 32>(s2, l); tr_step<4, 32>(s2, l); tr_step<2, 32>(s2, l); tr_step<1, 32>(s2, l);
        float t1 = s1[0] + __shfl_xor(s1[0], 32), t2 = s2[0] + __shfl_xor(s2[0], 32);
        if (l < 32) { part[(F.wave * 32 + l) * 2] = t1; part[(F.wave * 32 + l) * 2 + 1] = t2; }
        __syncthreads();
        t1 = 0.f; t2 = 0.f;
#pragma unroll
        for (int w = 0; w < 8; ++w) { t1 += part[(w * 32 + (l & 31)) * 2]; t2 += part[(w * 32 + (l & 31)) * 2 + 1]; }
        const float mean_l = t1 * (1.f / CW), rstd_l = rsqrtf(fmaxf(t2 * (1.f / CW) - mean_l * mean_l, 0.f) + LN_EPS);
#pragma unroll
        for (int r = 0; r < 32; ++r) {
            const float mean = __builtin_bit_cast(float, __builtin_amdgcn_readlane(__builtin_bit_cast(int, mean_l), r)), rstd = __builtin_bit_cast(float, __builtin_amdgcn_readlane(__builtin_bit_cast(int, rstd_l), r));
            const float v = (y[r] - mean) * rstd * lg + lb; const float z = v * pg8::sigm(v);
            aout[r * 512 + c] = (unsigned short)(pk2(z, 0.f) & 0xffffu);
        }
        __syncthreads();
        for (int i = F.tid; i < 32 * 64; i += NWAVES * 64) { const int rr = i >> 6, cc = i & 63; *(GAS v4u*)(ALN + (size_t)(r0 + rr) * CW + cc * 8) = *(const LAS v4u*)(aout + rr * 512 + cc * 8); }
    }
    __syncthreads();
}
typedef float f32x16_t __attribute__((ext_vector_type(16)));
__device__ __forceinline__ void p6_router(Frame& F, const bf16* x1, const float* g, const float* mod, const float* b_router) {
    LAS float* s_gs = (LAS float*)F.lds;
    LAS float* s_s0 = s_gs + 1024;
    LAS float* s_rstd = s_s0 + 1024;
    LAS float* s_part = s_rstd + 64;
    LAS float* s_log = s_part + 4 * 64 * 33;
    LAS int* lhist = (LAS int*)(F.lds + ROWTAB_OFF);
    if (F.tid < 32) lhist[F.tid] = 0;
    unsigned char* H8 = (unsigned char*)(F.ws + WS_H); int* TOPE = (int*)(F.ws + WS_TOPE); float* TOPG = (float*)(F.ws + WS_TOPG); int* LRANK = (int*)(F.ws + WS_LRANK); int* HIST = (int*)(F.ws + WS_HIST);
    const bf16* WRT = (const bf16*)(F.ws + WS_WRT);
    const int l = F.lane;
    for (int wg = blockIdx.x; wg < T / 64; wg += F.G) {
        const int b = (wg * 64) / SEQ; const float* sh = mod + (size_t)b * NMOD * D + 3 * D; const float* sc = sh + D;
        __syncthreads();
        for (int k = F.tid; k < D; k += NWAVES * 64) { s_gs[k] = g[k] * (sc[k] + 1.f); s_s0[k] = sh[k]; }
        __syncthreads();
        f32x4 gs[4], s0[4];
#pragma unroll
        for (int j = 0; j < 4; ++j) { gs[j] = *(const LAS f32x4*)(s_gs + 256 * j + 4 * l); s0[j] = *(const LAS f32x4*)(s_s0 + 256 * j + 4 * l); }
        f32x4 nx[4];
#pragma unroll
        for (int j = 0; j < 4; ++j) nx[j] = ld4bf(x1 + (size_t)(wg * 64 + F.wave * 8) * D + 256 * j + 4 * l);
#pragma unroll 1
        for (int i = 0; i < 8; ++i) {
            const int m = wg * 64 + F.wave * 8 + i;
            f32x4 v[4]; float ss = 0.f;
#pragma unroll
            for (int j = 0; j < 4; ++j) { v[j] = nx[j]; ss += (v[j].x * v[j].x + v[j].y * v[j].y) + (v[j].z * v[j].z + v[j].w * v[j].w); }
            if (i + 1 < 8) {
#pragma unroll
                for (int j = 0; j < 4; ++j) nx[j] = ld4bf(x1 + (size_t)(m + 1) * D + 256 * j + 4 * l);
            }
            const float rstd = rsqrtf(wave_sum(ss) * (1.f / D) + RMS_EPS);
            if (l == 0) s_rstd[F.wave * 8 + i] = rstd;
            GAS unsigned* o4 = (GAS unsigned*)(H8 + (size_t)m * D) + l;
#pragma unroll
            for (int j = 0; j < 4; ++j) { const f32x4 hv = v[j] * rstd * gs[j] + s0[j]; o4[64 * j] = pg8::pk4_fp8(hv.x, hv.y, hv.z, hv.w); }
        }
        __syncthreads();
        {
            const int th = F.wave & 1, kq = F.wave >> 1, r32 = l & 31, hi = l >> 5;
            const float rs = s_rstd[th * 32 + r32];
            const bf16* xa = x1 + (size_t)(wg * 64 + th * 32 + r32) * D + 256 * kq + 8 * hi;
            const bf16* wb = WRT + (size_t)r32 * D + 256 * kq + 8 * hi;
            f32x16_t acc = f32x16_t{};
#pragma unroll 4
            for (int st = 0; st < 16; ++st) {
                const v4u xw = *(const v4u*)(xa + 16 * st); const v4u wh = *(const v4u*)(wb + 16 * st), wl = *(const v4u*)(wb + NE * D + 16 * st);
                const int k0 = 256 * kq + 16 * st + 8 * hi;
                const f32x4 ga = *(const LAS f32x4*)(s_gs + k0), gb = *(const LAS f32x4*)(s_gs + k0 + 4), sa = *(const LAS f32x4*)(s_s0 + k0), sb = *(const LAS f32x4*)(s_s0 + k0 + 4);
                float hv[8];
                hv[0] = pg8::bf_lo(xw.x) * rs * ga.x + sa.x; hv[1] = pg8::bf_hi(xw.x) * rs * ga.y + sa.y; hv[2] = pg8::bf_lo(xw.y) * rs * ga.z + sa.z; hv[3] = pg8::bf_hi(xw.y) * rs * ga.w + sa.w;
                hv[4] = pg8::bf_lo(xw.z) * rs * gb.x + sb.x; hv[5] = pg8::bf_hi(xw.z) * rs * gb.y + sb.y; hv[6] = pg8::bf_lo(xw.w) * rs * gb.z + sb.z; hv[7] = pg8::bf_hi(xw.w) * rs * gb.w + sb.w;
                v4u ah, al;
                ah.x = pk2(hv[0], hv[1]); ah.y = pk2(hv[2], hv[3]); ah.z = pk2(hv[4], hv[5]); ah.w = pk2(hv[6], hv[7]);
                al.x = pk2(hv[0] - pg8::bf_lo(ah.x), hv[1] - pg8::bf_hi(ah.x)); al.y = pk2(hv[2] - pg8::bf_lo(ah.y), hv[3] - pg8::bf_hi(ah.y));
                al.z = pk2(hv[4] - pg8::bf_lo(ah.z), hv[5] - pg8::bf_hi(ah.z)); al.w = pk2(hv[6] - pg8::bf_lo(ah.w), hv[7] - pg8::bf_hi(ah.w));
                const pg8::bf16x8 Ah = __builtin_bit_cast(pg8::bf16x8, ah), Al = __builtin_bit_cast(pg8::bf16x8, al), Bh = __builtin_bit_cast(pg8::bf16x8, wh), Bl = __builtin_bit_cast(pg8::bf16x8, wl);
                acc = __builtin_amdgcn_mfma_f32_32x32x16_bf16(Ah, Bh, acc, 0, 0, 0);
                acc = __builtin_amdgcn_mfma_f32_32x32x16_bf16(Ah, Bl, acc, 0, 0, 0);
                acc = __builtin_amdgcn_mfma_f32_32x32x16_bf16(Al, Bh, acc, 0, 0, 0);
            }
#pragma unroll
            for (int r = 0; r < 16; ++r) { const int tok = th * 32 + (r & 3) + 8 * (r >> 2) + 4 * hi; s_part[(kq * 64 + tok) * 33 + r32] = acc[r]; }
        }
        __syncthreads();
        for (int i = F.tid; i < 64 * 32; i += NWAVES * 64) { const int tok = i >> 5, e = i & 31;
            s_log[tok * 33 + e] = (s_part[(0 * 64 + tok) * 33 + e] + s_part[(1 * 64 + tok) * 33 + e]) + (s_part[(2 * 64 + tok) * 33 + e] + s_part[(3 * 64 + tok) * 33 + e]) + b_router[e]; }
        __syncthreads();
#pragma unroll 1
        for (int grp = 0; grp < 4; ++grp) {
            const int row = l >> 5, e0 = l & 31, tk = F.wave * 8 + grp * 2 + row, m0 = wg * 64 + F.wave * 8 + grp * 2;
            float l0 = s_log[tk * 33 + e0];
            float tv[4]; int te[4];
#pragma unroll
            for (int k = 0; k < 4; ++k) {
                float bv = l0; int bi = e0;
#pragma unroll
                for (int st = 0; st < 4; ++st) { const float ov = dppf(bv, st); const int oi = dppi(bi, st); if (ov > bv || (ov == bv && oi < bi)) { bv = ov; bi = oi; } }
                { const float ov = __shfl_xor(bv, 16); const int oi = __shfl_xor(bi, 16); if (ov > bv || (ov == bv && oi < bi)) { bv = ov; bi = oi; } }
                tv[k] = bv; te[k] = bi;
                if (bi == e0) l0 = -INFINITY;
            }
            if ((l & 31) == 0) {
                const float e1 = expf(tv[1] - tv[0]), e2 = expf(tv[2] - tv[0]), e3 = expf(tv[3] - tv[0]); const float inv = 1.f / (1.f + e1 + e2 + e3);
                const int t = m0 + row;
                *(int4*)(TOPE + t * 4) = make_int4(te[0], te[1], te[2], te[3]);
                *(float4*)(TOPG + t * 4) = make_float4(inv, e1 * inv, e2 * inv, e3 * inv);
                int4 rk; rk.x = __hip_atomic_fetch_add(&lhist[te[0]], 1, __ATOMIC_RELAXED, __HIP_MEMORY_SCOPE_WORKGROUP); rk.y = __hip_atomic_fetch_add(&lhist[te[1]], 1, __ATOMIC_RELAXED, __HIP_MEMORY_SCOPE_WORKGROUP); rk.z = __hip_atomic_fetch_add(&lhist[te[2]], 1, __ATOMIC_RELAXED, __HIP_MEMORY_SCOPE_WORKGROUP); rk.w = __hip_atomic_fetch_add(&lhist[te[3]], 1, __ATOMIC_RELAXED, __HIP_MEMORY_SCOPE_WORKGROUP);
                *(int4*)(LRANK + t * 4) = rk;
            }
        }
        __syncthreads();
        { const int t2 = F.wave * 64 + fresh_lane();
          if (t2 < 32) { HIST[wg * 32 + t2] = lhist[t2]; lhist[t2] = 0; } }
        __syncthreads();
    }
}
__device__ __forceinline__ void p7_slots(Frame& F) {
    LAS int* s_tot = (LAS int*)F.lds; LAS int* s_pre = s_tot + 32; LAS int* s_tstart = s_tot + 64; LAS int* s_nt = s_tot + 128;
    const int* HIST = (const int*)(F.ws + WS_HIST); const int* TOPE = (const int*)(F.ws + WS_TOPE); const int* LRANK = (const int*)(F.ws + WS_LRANK);
    int* SLOT_TOK = (int*)(F.ws + WS_SLOT_TOK); int* TOK_SLOT = (int*)(F.ws + WS_TOK_SLOT); int* TILE_E = (int*)(F.ws + WS_TILE_E);
    constexpr int NBLK = T / 64;
    for (int wg = blockIdx.x; wg < NBLK; wg += F.G) {
        __syncthreads();
        if (F.tid < 256) {
            const int e = F.tid >> 3, sub = F.tid & 7; int tot = 0, pre = 0;
            for (int w = sub; w < NBLK; w += 8) { const int hcount = HIST[w * 32 + e]; tot += hcount; if (w < wg) pre += hcount; }
            tot += __shfl_xor(tot, 1); tot += __shfl_xor(tot, 2); tot += __shfl_xor(tot, 4); pre += __shfl_xor(pre, 1); pre += __shfl_xor(pre, 2); pre += __shfl_xor(pre, 4);
            if (sub == 0) { s_tot[e] = tot; s_pre[e] = pre; s_nt[e] = (tot + 255) >> 8; }
        }
        __syncthreads();
        if (F.tid == 0) { int s = 0; for (int e = 0; e < NE; ++e) { s_tstart[e] = s; s += s_nt[e]; } s_tstart[32] = s; }
        __syncthreads();
        if (F.tid < 256) { const int idx = wg * 256 + F.tid; const int e = TOPE[idx]; const int slot = 256 * s_tstart[e] + s_pre[e] + LRANK[idx]; TOK_SLOT[idx] = slot; SLOT_TOK[slot] = idx >> 2; }
        if (wg < NE) { const int e = wg; const int lo = 256 * s_tstart[e] + s_tot[e], hi = 256 * (s_tstart[e] + s_nt[e]); for (int s = lo + F.tid; s < hi; s += NWAVES * 64) SLOT_TOK[s] = 0; }
        if (wg == 0) { if (F.tid < NE) { for (int i = 0; i < s_nt[F.tid]; ++i) TILE_E[16 + s_tstart[F.tid] + i] = F.tid; } if (F.tid == 0) TILE_E[0] = s_tstart[32]; }
    }
    __syncthreads();
}
__device__ __forceinline__ void p10_final(Frame& F, const float* mod, const float* final_g, float* out) {
    const bf16* X1 = (const bf16*)(F.ws + WS_X1); const bf16* YB = (const bf16*)(F.ws + WS_YB); const int* TOK_SLOT = (const int*)(F.ws + WS_TOK_SLOT); const float* TOPG = (const float*)(F.ws + WS_TOPG);
    const int gw = F.vcu * NWAVES + F.wave, NGW = F.G * NWAVES, l = fresh_lane();
    for (int m = gw; m < T; m += NGW) {
        const int b = m / SEQ; const float* g2 = mod + (size_t)b * NMOD * D + 5 * D;
        const int4 sl = *(const int4*)(TOK_SLOT + m * 4); const float4 gt = *(const float4*)(TOPG + m * 4);
        const int s4[4] = {sl.x, sl.y, sl.z, sl.w}; const float g4[4] = {gt.x, gt.y, gt.z, gt.w};
        float y[16];
#pragma unroll
        for (int i = 0; i < 16; ++i) y[i] = 0.f;
#pragma unroll
        for (int k = 0; k < 4; ++k)
#pragma unroll
            for (int j = 0; j < 2; ++j) { const v4u a = *(const v4u*)(YB + (size_t)s4[k] * DE + 512 * j + 8 * l);
                y[8 * j + 0] += g4[k] * pg8::bf_lo(a.x); y[8 * j + 1] += g4[k] * pg8::bf_hi(a.x); y[8 * j + 2] += g4[k] * pg8::bf_lo(a.y); y[8 * j + 3] += g4[k] * pg8::bf_hi(a.y);
                y[8 * j + 4] += g4[k] * pg8::bf_lo(a.z); y[8 * j + 5] += g4[k] * pg8::bf_hi(a.z); y[8 * j + 6] += g4[k] * pg8::bf_lo(a.w); y[8 * j + 7] += g4[k] * pg8::bf_hi(a.w); }
        float ss = 0.f;
#pragma unroll
        for (int j = 0; j < 2; ++j) { const v4u xw = *(const v4u*)(X1 + (size_t)m * D + 512 * j + 8 * l);
            const float xf[8] = {pg8::bf_lo(xw.x), pg8::bf_hi(xw.x), pg8::bf_lo(xw.y), pg8::bf_hi(xw.y), pg8::bf_lo(xw.z), pg8::bf_hi(xw.z), pg8::bf_lo(xw.w), pg8::bf_hi(xw.w)};
#pragma unroll
            for (int q = 0; q < 2; ++q) { const int k0 = 512 * j + 8 * l + 4 * q; const f32x4 gv = *(const f32x4*)(g2 + k0);
                y[8 * j + 4 * q + 0] = xf[4 * q + 0] + gv.x * y[8 * j + 4 * q + 0]; y[8 * j + 4 * q + 1] = xf[4 * q + 1] + gv.y * y[8 * j + 4 * q + 1]; y[8 * j + 4 * q + 2] = xf[4 * q + 2] + gv.z * y[8 * j + 4 * q + 2]; y[8 * j + 4 * q + 3] = xf[4 * q + 3] + gv.w * y[8 * j + 4 * q + 3];
                ss += (y[8 * j + 4 * q] * y[8 * j + 4 * q] + y[8 * j + 4 * q + 1] * y[8 * j + 4 * q + 1]) + (y[8 * j + 4 * q + 2] * y[8 * j + 4 * q + 2] + y[8 * j + 4 * q + 3] * y[8 * j + 4 * q + 3]); } }
        const float rstd = rsqrtf(wave_sum(ss) * (1.f / D) + RMS_EPS);
#pragma unroll
        for (int j = 0; j < 2; ++j)
#pragma unroll
            for (int q = 0; q < 2; ++q) { const int k0 = 512 * j + 8 * l + 4 * q; const f32x4 fg = *(const f32x4*)(final_g + k0);
                f32x4 o; o.x = y[8 * j + 4 * q] * rstd * fg.x; o.y = y[8 * j + 4 * q + 1] * rstd * fg.y; o.z = y[8 * j + 4 * q + 2] * rstd * fg.z; o.w = y[8 * j + 4 * q + 3] * rstd * fg.w;
                *(GAS f32x4*)(out + (size_t)m * D + k0) = o; }
    }
}
__global__ void __launch_bounds__(NWAVES * 64, 2) mk_fwd(Args args) {
    extern __shared__ __attribute__((aligned(16))) unsigned char lds[];
    Frame F;
    F.lds = (LAS unsigned char*)lds; F.ws = args.ws;
    F.tid = threadIdx.x; F.lane = F.tid & 63; F.wave = __builtin_amdgcn_readfirstlane(F.tid >> 6);
    F.G = gridDim.x; { const int bx = blockIdx.x; F.vcu = (F.G % 8 == 0) ? (bx % 8) * (F.G / 8) + bx / 8 : bx; }
    volatile LAS unsigned* MISC = (volatile LAS unsigned*)(F.lds + MISC_OFF);
    for (int u = F.tid; u < (ROWTAB_OFF - LDSCTL_OFF) / 4; u += NWAVES * 64) ((LAS unsigned*)(F.lds + LDSCTL_OFF))[u] = 0u;
    __syncthreads();
    XcdBarrier bar; bar.bar = (unsigned*)(args.ws + WS_CTL) + CW_BAR; bar.x = 0; bar.st = nullptr;
    if (MK_N_LAUNCHES == 1) bar = xcd_barrier_post((unsigned*)(args.ws + WS_CTL) + CW_BAR, MISC + 8);
    const int lo = args.ph_lo, hi = args.ph_hi;
#define IN(k) (lo <= (k) && (k) < hi)
#define SEAM(k) do { if (IN(k) && IN((k) + 1)) xcd_barrier(bar); } while (0)
    const float* x = args.in[0]; const float* mod = (const float*)(args.ws + WS_MOD);
    unsigned char* ws = args.ws;

    if (IN(0)) { { p0_mod(F, args.in[1], args.in[2], args.in[3], (float*)(ws + WS_MOD)); p0_router_w(F, args.in[15]); p0_convert(F, args.in[5], args.in[11], args.in[12], args.in[13], args.in[17], args.in[19]); } SEAM(0); }
    if (IN(1)) { { p1_norm1(F, x, args.in[4], mod, args.in[5], args.in[6]); } SEAM(1); }
    if (IN(2)) { {
        for (int bh = blockIdx.x; bh < BATCH * NH; bh += F.G) p2_fscan(F, bh);
        pg8::DenseSched S; S.init(ws + WS_H, ws + WS_WIN, T, NIN, D / 2, F.G, (int)blockIdx.x);
        static_assert(WS_K - WS_Q == WS_V - WS_K, "q|k|v spacing");
        pg8::EpiIn E{(bf16*)(ws + WS_AGLU), (bf16*)(ws + WS_Q), (bf16*)(ws + WS_SGC), (WS_K - WS_Q) / 2, (WS_SGA - WS_SGC) / 2, attn_body::C2, (unsigned*)(ws + WS_CTL + CTL_NORM), SEQ, 0.03125f};
        pg8::gemm_phase8<pg8::EpiIn, pg8::DenseSched, true>(F.lds, D / 2, S, E); }
        phase_main_done(F, 2); cvt_fill(F, args.in[17], args.in[19], 2, MISC);
        SEAM(2);
    }
    if (IN(3)) {
        static_assert(attn_body::ATTN_LDS_BYTES <= RING_BYTES, "attention LDS");
        const attn_body::AttnTensors AT{(const attn_body::bf16*)(ws + WS_Q), (const attn_body::bf16*)(ws + WS_K), (const attn_body::bf16*)(ws + WS_V), (const unsigned*)(ws + WS_KX), (attn_body::bf16*)(ws + WS_ATT)};
        const attn_body::AttnQueue AQ{(unsigned*)(ws + WS_CTL + CTL_QCTR), (const float*)(ws + WS_BIAS), (const float*)(ws + WS_CTL + CTL_NORM), 512};
        attn_body::attn_phase<8>((char*)lds, MISC, AT, AQ);
        p3_conv(F, args.in[7], args.in[8], args.in[9], args.in[10], MISC, 1);
        phase_main_done(F, 3); cvt_fill(F, args.in[17], args.in[19], 3, MISC);
        SEAM(3);
    }
    if (IN(4)) { {
        pg8::PairSched S{(const char*)(ws + WS_ALN), (const char*)(ws + WS_WC), (const char*)(ws + WS_ATT), (const char*)(ws + WS_WA), CW, T / 256, D / 256, (T / 256) * (D / 256), F.G, (int)blockIdx.x};
        pg8::EpiMix E{(const bf16*)(ws + WS_SGC), (WS_SGA - WS_SGC) / 2, (bf16*)(ws + WS_MIX)};
        pg8::gemm_phase<pg8::EpiMix, pg8::PairSched, true>(F.lds, CW, S, E); }
        SEAM(4);
    }
    if (IN(5)) { {
        pg8::DenseSched S; S.init(ws + WS_MIX, ws + WS_WO, T, D, D, F.G, (int)blockIdx.x);
        pg8::EpiRes E{x, mod + 2 * D, (bf16*)(ws + WS_X1), SEQ, NMOD * D};
        pg8::gemm_phase<pg8::EpiRes, pg8::DenseSched, false>(F.lds, D, S, E); }
        SEAM(5);
    }
    if (IN(6)) { { p6_router(F, (const bf16*)(ws + WS_X1), args.in[14], mod, args.in[16]); } SEAM(6); }
    if (IN(7)) { { p7_slots(F); } cvt_fill(F, args.in[17], args.in[19], 0, MISC); SEAM(7); }
    if (IN(8)) { {
        const int* TILE_E = (const int*)(ws + WS_TILE_E); const int ntiles = TILE_E[0]; const int Wd = (F.G % 8 == 0) ? F.G / 8 : F.G, NG = (F.G % 8 == 0) ? 8 : 1;
        LAS int* rows = (LAS int*)(F.lds + ROWTAB_OFF);
        pg8::MoeSched<8, true> S{(const char*)(ws + WS_H), (const char*)(ws + WS_W1), TILE_E + 16, D / 2, 8 * ntiles, (8 * ntiles + NG - 1) / NG, F.vcu / Wd, F.vcu % Wd, Wd, (size_t)2 * DE * D, rows};
        const int* SLOT_TOK = (const int*)(ws + WS_SLOT_TOK);
        for (int i = 0; i < ROWTAB_UNITS; ++i) { pg8::Unit u; if (!S.next(i, u)) break; if (F.tid < 256) rows[i * 256 + F.tid] = SLOT_TOK[u.pm * 256 + F.tid]; }
        __syncthreads();
        pg8::EpiSwiglu8 E{args.in[18], (unsigned char*)(ws + WS_HM)};
        pg8::gemm_phase8<pg8::EpiSwiglu8, pg8::MoeSched<8, true>, true>(F.lds, D / 2, S, E); }
        SEAM(8);
    }
    if (IN(9)) { {
        const int* TILE_E = (const int*)(ws + WS_TILE_E); const int ntiles = TILE_E[0]; const int Wd = (F.G % 8 == 0) ? F.G / 8 : F.G, NG = (F.G % 8 == 0) ? 8 : 1;
        pg8::MoeSched<4, false> S{(const char*)(ws + WS_HM), (const char*)(ws + WS_W2), TILE_E + 16, DE / 2, 4 * ntiles, (4 * ntiles + NG - 1) / NG, F.vcu / Wd, F.vcu % Wd, Wd, (size_t)D * DE, nullptr};
        pg8::EpiYb8 E{args.in[20], (bf16*)(ws + WS_YB)};
        pg8::gemm_phase8<pg8::EpiYb8, pg8::MoeSched<4, false>, true>(F.lds, DE / 2, S, E); }
        SEAM(9);
    }
    if (IN(10)) { { p10_final(F, mod, args.in[21], args.out); } }
#undef IN
#undef SEAM
}

extern "C" void kernel_launch(void* const* d_in, const int* in_sizes, int n_in, void* d_out, int out_size, void* d_ws, size_t ws_size, hipStream_t stream) {
    static int grid = 0;
    if (grid == 0) {
        if (n_in != 22 || in_sizes[0] != T * D || out_size != T * D || ws_size < WS_END) { fprintf(stderr, "kernel_launch: unexpected shapes / workspace (n_in %d, ws %zu); nothing launched\n", n_in, ws_size); grid = -1; return; }
        int dev = 0, cus = 0, per_cu = 0;
        if (hipGetDevice(&dev) != hipSuccess || hipDeviceGetAttribute(&cus, hipDeviceAttributeMultiprocessorCount, dev) != hipSuccess) { grid = -1; return; }
        if (hipFuncSetAttribute((const void*)mk_fwd, hipFuncAttributeMaxDynamicSharedMemorySize, LDS_BYTES) != hipSuccess) { fprintf(stderr, "kernel_launch: hipFuncSetAttribute failed\n"); grid = -1; return; }
        if (hipOccupancyMaxActiveBlocksPerMultiprocessor(&per_cu, (const void*)mk_fwd, NWAVES * 64, LDS_BYTES) != hipSuccess || per_cu < 1) fprintf(stderr, "kernel_launch: occupancy query reports %d\n", per_cu);
        (void)hipGetLastError();
        grid = cus;
    }
    if (grid < 0) return;
    if (hipMemsetAsync((char*)d_ws + WS_CTL, 0, CTL_ZERO_BYTES, stream) != hipSuccess) return;
    Args a{};
    for (int i = 0; i < 22; ++i) a.in[i] = (const float*)d_in[i];
    a.out = (float*)d_out; a.ws = (unsigned char*)d_ws;
    if (MK_N_LAUNCHES == 1) { a.ph_lo = 0; a.ph_hi = NPH; hipLaunchKernelGGL(mk_fwd, dim3(grid), dim3(NWAVES * 64), LDS_BYTES, stream, a); }
    else for (int p = 0; p < NPH; ++p) { a.ph_lo = p; a.ph_hi = p + 1; hipLaunchKernelGGL(mk_fwd, dim3(grid), dim3(NWAVES * 64), LDS_BYTES, stream, a); }
}
```

```cpp
#include <hip/hip_runtime.h>
#include <hip/hip_bf16.h>
#include <cstdio>
#include <cstdint>
#include <cmath>

namespace pg8 {
#define PG8_LAS __attribute__((address_space(3)))
typedef unsigned short bf16_t;
typedef short bf16x8 __attribute__((ext_vector_type(8)));
typedef float f32x4 __attribute__((ext_vector_type(4)));
typedef unsigned u32x4 __attribute__((ext_vector_type(4)));
typedef unsigned u32x2 __attribute__((ext_vector_type(2)));
typedef int v8i __attribute__((ext_vector_type(8)));
constexpr int BM = 256, BK = 64, HALF = 128, HTB = HALF * BK * 2  , STAGE_BYTES = 8 * HTB, NXCD = 8, WGM = 8;

__host__ __device__ __forceinline__ int lds_byte(int r, int c) { const int st = (r >> 4) * 2 + (c >> 5), rr = r & 15, cc = c & 31, ob = rr * 64 + cc * 2; return st * 1024 + (ob ^ (((ob >> 9) & 1) << 5)); }
__host__ __device__ __forceinline__ void stage_rc(int b, int& R, int& C) { const int st = b / 1024, sb = b % 1024, swz = sb ^ (((sb >> 9) & 1) << 5); R = (st >> 1) * 16 + swz / 64; C = (st & 1) * 32 + (swz % 64) / 2; }
__host__ __device__ __forceinline__ int perm32(int rho) { const int n = rho >> 4, i = rho & 15; return 8 * (i >> 2) + 4 * n + (i & 3); }

struct Unit { int pm, pn, aux, li; const char* A; const char* B; };

__device__ __forceinline__ void tile_of(int L, int nM, int nN, int& pm, int& pn) {
    const int nwg = nM * nN; int wgid = L; { const int q = nwg / NXCD, r = nwg % NXCD, xcd = wgid % NXCD, off = wgid / NXCD; wgid = (xcd < r ? xcd * (q + 1) : r * (q + 1) + (xcd - r) * q) + off; }
    const int nig = WGM * nN, gid = wgid / nig, fm = gid * WGM, gsz = (nM - fm) < WGM ? (nM - fm) : WGM;
    pm = fm + ((wgid % nig) % gsz); pn = (wgid % nig) / gsz;
}
struct DenseSched {
    const char* A; const char* Bt; int K, nM, nN, nwg, G, c;
    __device__ __forceinline__ void init(const void* A_, const void* Bt_, int M, int N, int K_, int G_, int c_) { A = (const char*)A_; Bt = (const char*)Bt_; K = K_; nM = M / BM; nN = N / BM; nwg = nM * nN; G = G_; c = c_; }
    __device__ __forceinline__ bool next(int i, Unit& u) const {
        const long L = (long)i * G + c; if (L >= nwg) return false;
        tile_of((int)L, nM, nN, u.pm, u.pn); u.aux = 0; u.li = i; u.A = A + (size_t)u.pm * BM * K * 2; u.B = Bt + (size_t)u.pn * BM * K * 2; return true;
    }
    __device__ __forceinline__ void aoff(const Unit&, const int (&R)[2], const int (&Cb)[2], unsigned (&o)[2][2]) const {
#pragma unroll
        for (int h = 0; h < 2; ++h)
#pragma unroll
            for (int i = 0; i < 2; ++i) o[h][i] = (unsigned)((h * HALF + R[i]) * K * 2 + Cb[i]);
    }
};
struct PairSched {
    const char *A0, *B0, *A1, *B1; int K, nM, nN, nwg, G, c;
    __device__ __forceinline__ bool next(int i, Unit& u) const {
        const long L = (long)(i >> 1) * G + c; if (L >= nwg) return false;
        tile_of((int)L, nM, nN, u.pm, u.pn); u.aux = i & 1; u.li = i;
        u.A = ((i & 1) ? A1 : A0) + (size_t)u.pm * BM * K * 2; u.B = ((i & 1) ? B1 : B0) + (size_t)u.pn * BM * K * 2; return true;
    }
    __device__ __forceinline__ void aoff(const Unit&, const int (&R)[2], const int (&Cb)[2], unsigned (&o)[2][2]) const {
#pragma unroll
        for (int h = 0; h < 2; ++h)
#pragma unroll
            for (int i = 0; i < 2; ++i) o[h][i] = (unsigned)((h * HALF + R[i]) * K * 2 + Cb[i]);
    }
};
template <int NT_N, bool GATHER> struct MoeSched {
    const char* A; const char* W; const int* tile_e; int K, U, PER, x, r, Wd; size_t wstride_e; PG8_LAS const int* rows;
    __device__ __forceinline__ bool next(int i, Unit& u) const {
        const int q = i * Wd + r; if (q >= PER) return false; const int g = x * PER + q; if (g >= U) return false;
        const int tile = g / NT_N, pn = g % NT_N; const int e = tile_e[tile];
        u.pm = tile; u.pn = pn; u.aux = e; u.li = i; u.A = GATHER ? A : A + (size_t)tile * BM * K * 2; u.B = W + (size_t)e * wstride_e + (size_t)pn * BM * K * 2; return true;
    }
    __device__ __forceinline__ void aoff(const Unit& u, const int (&R)[2], const int (&Cb)[2], unsigned (&o)[2][2]) const {
#pragma unroll
        for (int h = 0; h < 2; ++h)
#pragma unroll
            for (int i = 0; i < 2; ++i) { const int rr = h * HALF + R[i]; o[h][i] = GATHER ? (unsigned)(rows[u.li * 256 + rr] * K * 2 + Cb[i]) : (unsigned)(rr * K * 2 + Cb[i]); }
    }
};

typedef float f32x2_c __attribute__((ext_vector_type(2))); typedef __bf16 bf16x2_c __attribute__((ext_vector_type(2)));
__device__ __forceinline__ unsigned cvt_pk_bf16(float lo, float hi) { const f32x2_c v = {lo, hi}; const bf16x2_c b = __builtin_convertvector(v, bf16x2_c); return __builtin_bit_cast(unsigned, b); }
__device__ __forceinline__ float bf_lo(unsigned u) { return __builtin_bit_cast(float, u << 16); }
__device__ __forceinline__ float bf_hi(unsigned u) { return __builtin_bit_cast(float, u & 0xffff0000u); }
__device__ __forceinline__ float sigm(float x) { return __builtin_amdgcn_rcpf(1.f + __builtin_amdgcn_exp2f(-1.4426950408889634f * x)); }

typedef f32x4 Acc[2][2][4][2];

struct EpiIn {
    static constexpr bool PERM = true;
    struct Pre { int none; };
    __device__ __forceinline__ Pre pre(const Unit&, int, int) const { return Pre{0}; }
    bf16_t *AGLU, *QKV, *SG; size_t qkv_stride, sg_stride; float qscale; unsigned* NORM; int rows_per_batch; float ascale;
    __device__ __forceinline__ void operator()(const Acc& acc, const Unit& u, const Pre&, int wr, int wc, int fr, int fq) const {
        const int row0 = u.pm * BM + wr * 64 + fr; const int pn = u.pn;
        if (pn < 4) {
#pragma unroll
            for (int ai = 0; ai < 2; ++ai)
#pragma unroll
                for (int m = 0; m < 4; ++m) { bf16_t* rowp = AGLU + (size_t)(row0 + ai * HALF + m * 16) * 512 + pn * 128 + wc * 32 + 8 * fq;
                    const f32x4 v0 = acc[ai][0][m][0] * ascale, v1 = acc[ai][0][m][1] * ascale, g0 = acc[ai][1][m][0] * ascale, g1 = acc[ai][1][m][1] * ascale;
                    u32x4 w; w.x = cvt_pk_bf16(v0[0] * sigm(g0[0]), v0[1] * sigm(g0[1])); w.y = cvt_pk_bf16(v0[2] * sigm(g0[2]), v0[3] * sigm(g0[3]));
                    w.z = cvt_pk_bf16(v1[0] * sigm(g1[0]), v1[1] * sigm(g1[1])); w.w = cvt_pk_bf16(v1[2] * sigm(g1[2]), v1[3] * sigm(g1[3]));
                    *(u32x4*)rowp = w; }
        } else if (pn < 10) {
            const int t = (pn - 4) >> 1; bf16_t* base = QKV + (size_t)t * qkv_stride; const float sc = ((t == 0) ? qscale : 1.f) * ascale;
            const int col0 = ((pn - 4) & 1) * 256 + wc * 32 + 8 * fq; float nmx[2] = {0.f, 0.f};
#pragma unroll
            for (int ai = 0; ai < 2; ++ai)
#pragma unroll
                for (int m = 0; m < 4; ++m) { bf16_t* rowp = base + (size_t)(row0 + ai * HALF + m * 16) * 512 + col0;
#pragma unroll
                    for (int bj = 0; bj < 2; ++bj) { const f32x4 v0 = acc[ai][bj][m][0] * sc, v1 = acc[ai][bj][m][1] * sc;
                        if (t < 2) { float ssq = (v0[0] * v0[0] + v0[1] * v0[1]) + (v0[2] * v0[2] + v0[3] * v0[3]) + (v1[0] * v1[0] + v1[1] * v1[1]) + (v1[2] * v1[2] + v1[3] * v1[3]);
                            ssq += __shfl_xor(ssq, 16); ssq += __shfl_xor(ssq, 32); nmx[bj] = fmaxf(nmx[bj], ssq); }
                        u32x4 w; w.x = cvt_pk_bf16(v0[0], v0[1]); w.y = cvt_pk_bf16(v0[2], v0[3]); w.z = cvt_pk_bf16(v1[0], v1[1]); w.w = cvt_pk_bf16(v1[2], v1[3]);
                        *(u32x4*)(rowp + bj * HALF) = w; } }
            if (t < 2) {
#pragma unroll
                for (int bj = 0; bj < 2; ++bj) { float r = nmx[bj];
#pragma unroll
                    for (int o = 1; o < 16; o <<= 1) r = fmaxf(r, __shfl_xor(r, o));
                    const int head = ((pn - 4) & 1) * 4 + bj * 2 + (wc >> 1), bb = (u.pm * BM) / rows_per_batch;
                    if ((threadIdx.x & 63) == 0) atomicMax(NORM + (bb * 8 + head) * 2 + t, __builtin_bit_cast(unsigned, r)); } }
        } else {
            const int t = (pn - 10) >> 2; unsigned char* base = (unsigned char*)SG + (size_t)t * sg_stride * 2; const int col0 = ((pn - 10) & 3) * 256 + wc * 32 + 8 * fq;
#pragma unroll
            for (int ai = 0; ai < 2; ++ai)
#pragma unroll
                for (int m = 0; m < 4; ++m) { unsigned char* rowp = base + (size_t)(row0 + ai * HALF + m * 16) * 1024 + col0;
#pragma unroll
                    for (int bj = 0; bj < 2; ++bj) { const f32x4 v0 = acc[ai][bj][m][0] * ascale, v1 = acc[ai][bj][m][1] * ascale;
                        unsigned q[8];
#pragma unroll
                        for (int j = 0; j < 4; ++j) { q[j] = (unsigned)(sigm(v0[j]) * 255.f + 0.5f); q[4 + j] = (unsigned)(sigm(v1[j]) * 255.f + 0.5f); }
                        u32x2 w; w.x = q[0] | (q[1] << 8) | (q[2] << 16) | (q[3] << 24); w.y = q[4] | (q[5] << 8) | (q[6] << 16) | (q[7] << 24);
                        *(u32x2*)(rowp + bj * HALF) = w; } }
        }
    }
};
struct EpiMix {
    static constexpr bool PERM = true;
    __device__ static __forceinline__ bool keep(const Unit& u) { return u.aux == 0; }
    const bf16_t* SG; size_t sg_stride; bf16_t* MIX;
    __device__ __forceinline__ void operator()(Acc& acc, const Unit& u, int wr, int wc, int fr, int fq) const {
        const int row0 = u.pm * BM + wr * 64 + fr, col0 = u.pn * BM + wc * 32 + 8 * fq; const unsigned char* GC = (const unsigned char*)SG; const unsigned char* GA = GC + sg_stride * 2;
#pragma unroll
        for (int ai = 0; ai < 2; ++ai) {
            u32x2 ga[4][2], gc[4][2];
#pragma unroll
            for (int m = 0; m < 4; ++m)
#pragma unroll
                for (int bj = 0; bj < 2; ++bj) { const size_t ro = (size_t)(row0 + ai * HALF + m * 16) * 1024 + col0 + bj * HALF; ga[m][bj] = (u.aux == 0) ? *(const u32x2*)(GA + ro) : __builtin_nontemporal_load((const u32x2*)(GA + ro));
                    if (u.aux == 0) gc[m][bj] = __builtin_nontemporal_load((const u32x2*)(GC + ro)); }
            asm volatile("" ::: "memory");
#pragma unroll
            for (int m = 0; m < 4; ++m)
#pragma unroll
                for (int bj = 0; bj < 2; ++bj) { const size_t ro = (size_t)(row0 + ai * HALF + m * 16) * 1024 + col0 + bj * HALF; const u32x2 a = ga[m][bj];
                    float fa[8] = {(float)(a.x & 255u), (float)((a.x >> 8) & 255u), (float)((a.x >> 16) & 255u), (float)(a.x >> 24), (float)(a.y & 255u), (float)((a.y >> 8) & 255u), (float)((a.y >> 16) & 255u), (float)(a.y >> 24)};
#pragma unroll
                    for (int j = 0; j < 8; ++j) fa[j] = fmaxf(fa[j], 9.5367431640625e-7f);
                    if (u.aux == 0) { const u32x2 c = gc[m][bj];
                        const float fc[8] = {(float)(c.x & 255u), (float)((c.x >> 8) & 255u), (float)((c.x >> 16) & 255u), (float)(c.x >> 24), (float)(c.y & 255u), (float)((c.y >> 8) & 255u), (float)((c.y >> 16) & 255u), (float)(c.y >> 24)};
#pragma unroll
                        for (int j = 0; j < 4; ++j) { acc[ai][bj][m][0][j] *= fc[j] * __builtin_amdgcn_rcpf(fa[j]); acc[ai][bj][m][1][j] *= fc[4 + j] * __builtin_amdgcn_rcpf(fa[4 + j]); }
                    } else { const f32x4 v0 = acc[ai][bj][m][0] * (1.f / 255.f), v1 = acc[ai][bj][m][1] * (1.f / 255.f);
                        u32x4 w; w.x = cvt_pk_bf16(fa[0] * v0[0], fa[1] * v0[1]); w.y = cvt_pk_bf16(fa[2] * v0[2], fa[3] * v0[3]); w.z = cvt_pk_bf16(fa[4] * v1[0], fa[5] * v1[1]); w.w = cvt_pk_bf16(fa[6] * v1[2], fa[7] * v1[3]);
                        *(u32x4*)(MIX + ro) = w; } }
        }
    }
};
struct EpiRes {
    static constexpr bool PERM = true;
    __device__ static __forceinline__ bool keep(const Unit&) { return false; }
    const float* X; const float* G1; bf16_t* X1; int rows_per_batch; int gstride;
    __device__ __forceinline__ void operator()(const Acc& acc, const Unit& u, int wr, int wc, int fr, int fq) const {
        const int row0 = u.pm * BM + wr * 64 + fr, col0 = u.pn * BM + wc * 32 + 8 * fq;
        const float* g = G1 + (size_t)((u.pm * BM) / rows_per_batch) * gstride + col0;
        f32x4 gv[2][2];
#pragma unroll
        for (int bj = 0; bj < 2; ++bj)
#pragma unroll
            for (int n = 0; n < 2; ++n) gv[bj][n] = *(const f32x4*)(g + bj * HALF + 4 * n);
#pragma unroll
        for (int ai = 0; ai < 2; ++ai) {
            f32x4 xq[4][2][2];
#pragma unroll
            for (int m = 0; m < 4; ++m)
#pragma unroll
                for (int bj = 0; bj < 2; ++bj) { const size_t o = (size_t)(row0 + ai * HALF + m * 16) * 1024 + col0 + bj * HALF; xq[m][bj][0] = *(const f32x4*)(X + o); xq[m][bj][1] = *(const f32x4*)(X + o + 4); }
            asm volatile("" ::: "memory");
#pragma unroll
            for (int m = 0; m < 4; ++m)
#pragma unroll
                for (int bj = 0; bj < 2; ++bj) { const size_t o = (size_t)(row0 + ai * HALF + m * 16) * 1024 + col0 + bj * HALF;
                    const f32x4 v0 = xq[m][bj][0] + gv[bj][0] * acc[ai][bj][m][0], v1 = xq[m][bj][1] + gv[bj][1] * acc[ai][bj][m][1];
                    u32x4 w; w.x = cvt_pk_bf16(v0[0], v0[1]); w.y = cvt_pk_bf16(v0[2], v0[3]); w.z = cvt_pk_bf16(v1[0], v1[1]); w.w = cvt_pk_bf16(v1[2], v1[3]);
                    *(u32x4*)(X1 + o) = w; }
        }
    }
};
__device__ __forceinline__ unsigned pk4_fp8(float a, float b, float c, float d) { int w = 0; w = __builtin_amdgcn_cvt_pk_fp8_f32(a, b, w, false); w = __builtin_amdgcn_cvt_pk_fp8_f32(c, d, w, true); return (unsigned)w; }
typedef float f32x2 __attribute__((ext_vector_type(2)));
__device__ __forceinline__ f32x2 swiglu2(f32x2 ga, f32x2 ua, f32x2 bg, f32x2 bu) {
    f32x2 g = ga * 0.03125f + bg, u = ua * 0.03125f + bu;
    g.x = fminf(g.x, 7.f); g.y = fminf(g.y, 7.f); u.x = fminf(fmaxf(u.x, -7.f), 7.f); u.y = fminf(fmaxf(u.y, -7.f), 7.f);
    const f32x2 t = g * (-1.702f * 1.4426950408889634f);
    f32x2 e; e.x = __builtin_amdgcn_exp2f(t.x); e.y = __builtin_amdgcn_exp2f(t.y);
    const f32x2 d = e + 1.f;
    f32x2 r; r.x = __builtin_amdgcn_rcpf(d.x); r.y = __builtin_amdgcn_rcpf(d.y);
    const f32x2 s = g * r;
    return u * s + s;
}
struct EpiSwiglu8 {
    static constexpr bool PERM = true;
    const float* B1; unsigned char* HM8;
    struct Pre { f32x4 bg0, bg1, bu0, bu1; };
    __device__ __forceinline__ Pre pre(const Unit& u, int wc, int fq) const { const int colh = u.pn * 128 + wc * 32 + 8 * fq; const float* b1 = B1 + (size_t)u.aux * 2048;
        Pre p; p.bg0 = *(const f32x4*)(b1 + colh); p.bg1 = *(const f32x4*)(b1 + colh + 4); p.bu0 = *(const f32x4*)(b1 + 1024 + colh); p.bu1 = *(const f32x4*)(b1 + 1024 + colh + 4); return p; }
    __device__ __forceinline__ void operator()(const Acc& acc, const Unit& u, const Pre& P, int wr, int wc, int fr, int fq) const {
        const int row0 = u.pm * BM + wr * 64 + fr, colh = u.pn * 128 + wc * 32 + 8 * fq;
        const f32x4 bg0 = P.bg0, bg1 = P.bg1, bu0 = P.bu0, bu1 = P.bu1;
#pragma unroll
        for (int ai = 0; ai < 2; ++ai)
#pragma unroll
            for (int m = 0; m < 4; ++m) { unsigned char* rowp = HM8 + (size_t)(row0 + ai * HALF + m * 16) * 1024 + colh;
                const f32x4 ga0 = acc[ai][0][m][0], ga1 = acc[ai][0][m][1], ua0 = acc[ai][1][m][0], ua1 = acc[ai][1][m][1];
                const f32x2 o0 = swiglu2(ga0.xy, ua0.xy, bg0.xy, bu0.xy), o1 = swiglu2(ga0.zw, ua0.zw, bg0.zw, bu0.zw), o2 = swiglu2(ga1.xy, ua1.xy, bg1.xy, bu1.xy), o3 = swiglu2(ga1.zw, ua1.zw, bg1.zw, bu1.zw);
                const float o[8] = {o0.x, o0.y, o1.x, o1.y, o2.x, o2.y, o3.x, o3.y};
                u32x2 w; w.x = pk4_fp8(o[0], o[1], o[2], o[3]); w.y = pk4_fp8(o[4], o[5], o[6], o[7]);
                *(u32x2*)rowp = w; }
    }
};
struct EpiYb8 {
    static constexpr bool PERM = true;
    const float* B2; bf16_t* YB;
    struct Pre { f32x4 bv[2][2]; };
    __device__ __forceinline__ Pre pre(const Unit& u, int wc, int fq) const { const float* b2 = B2 + (size_t)u.aux * 1024 + u.pn * BM + wc * 32 + 8 * fq; Pre p;
#pragma unroll
        for (int bj = 0; bj < 2; ++bj)
#pragma unroll
            for (int n = 0; n < 2; ++n) p.bv[bj][n] = *(const f32x4*)(b2 + bj * HALF + 4 * n);
        return p; }
    __device__ __forceinline__ void operator()(const Acc& acc, const Unit& u, const Pre& P, int wr, int wc, int fr, int fq) const {
        const int row0 = u.pm * BM + wr * 64 + fr, col0 = u.pn * BM + wc * 32 + 8 * fq;
#pragma unroll
        for (int ai = 0; ai < 2; ++ai)
#pragma unroll
            for (int m = 0; m < 4; ++m) { unsigned char* rowp = (unsigned char*)YB + (size_t)(row0 + ai * HALF + m * 16) * 1024 + col0;
#pragma unroll
                for (int bj = 0; bj < 2; ++bj) { const f32x4 v0 = acc[ai][bj][m][0] * 0.03125f + P.bv[bj][0], v1 = acc[ai][bj][m][1] * 0.03125f + P.bv[bj][1];
                    u32x2 w; w.x = pk4_fp8(v0[0], v0[1], v0[2], v0[3]); w.y = pk4_fp8(v1[0], v1[1], v1[2], v1[3]);
                    *(u32x2*)(rowp + bj * HALF) = w; } }
    }
};


template <class Epi, class Sched, bool ALIGN_EPI>
__device__ __forceinline__ void gemm_phase(PG8_LAS unsigned char* lds, const int K, const Sched& S, const Epi& E) {
    const int tid = threadIdx.x, wid = __builtin_amdgcn_readfirstlane(tid >> 6), lane = tid & 63, wr = wid >> 2, wc = wid & 3, fr = lane & 15, fq = lane >> 4;
    const int nt = K / BK;
    int R[2], Cb[2]; unsigned voffB[2];
#pragma unroll
    for (int i = 0; i < 2; ++i) { int R_, C_; stage_rc(tid * 16 + i * 8192, R_, C_); const int Rb = Epi::PERM ? ((R_ & ~31) + perm32(R_ & 31)) : R_;
        R[i] = R_; Cb[i] = C_ * 2; voffB[i] = (unsigned)(Rb * K + C_) * 2u; }
    const size_t kstep = (size_t)(BK * 2);
    const size_t hstep = (size_t)HALF * K * 2;
    const unsigned ldsw = (unsigned)wid * 1024u;
    const int aoffl = lds_byte(wr * 64 + fr, fq * 8), boffl = lds_byte(wc * 32 + fr, fq * 8);
#define PG8_SA(b, h) (((b) * 2 + (h)) * HTB)
#define PG8_SB(b, h) ((4 + (b) * 2 + (h)) * HTB)
#define PG8_STAGE_B(bufoff, gbase) do { _Pragma("unroll") for (int _i = 0; _i < 2; ++_i) \
        __builtin_amdgcn_global_load_lds((const unsigned*)((const char*)(gbase) + voffB[_i]), (PG8_LAS unsigned*)(lds + (bufoff) + ldsw + _i * 8192), 16, 0, 0); } while (0)
#define PG8_STAGE_A(bufoff, gbase, o0, o1) do { \
        __builtin_amdgcn_global_load_lds((const unsigned*)((const char*)(gbase) + (o0)), (PG8_LAS unsigned*)(lds + (bufoff) + ldsw), 16, 0, 0); \
        __builtin_amdgcn_global_load_lds((const unsigned*)((const char*)(gbase) + (o1)), (PG8_LAS unsigned*)(lds + (bufoff) + ldsw + 8192), 16, 0, 0); } while (0)
#define PG8_LDA(dst, b, h) do { _Pragma("unroll") for (int m = 0; m < 4; ++m) _Pragma("unroll") for (int k = 0; k < 2; ++k) dst[m][k] = *(const PG8_LAS bf16x8*)(lds + PG8_SA(b, h) + aoffl + m * 2048 + k * 1024); } while (0)
#define PG8_LDB(dst, b, h) do { _Pragma("unroll") for (int n = 0; n < 2; ++n) _Pragma("unroll") for (int k = 0; k < 2; ++k) dst[n][k] = *(const PG8_LAS bf16x8*)(lds + PG8_SB(b, h) + boffl + n * 2048 + k * 1024); } while (0)
#define PG8_MMA(ai, bj, At, Bt) do { __builtin_amdgcn_s_setprio(1); _Pragma("unroll") for (int m = 0; m < 4; ++m) _Pragma("unroll") for (int n = 0; n < 2; ++n) _Pragma("unroll") for (int k = 0; k < 2; ++k) \
        acc[ai][bj][m][n] = __builtin_amdgcn_mfma_f32_16x16x32_bf16(Bt[n][k], At[m][k], acc[ai][bj][m][n], 0, 0, 0); __builtin_amdgcn_s_setprio(0); } while (0)
#define PG8_WAIT_V(n) asm volatile("s_waitcnt vmcnt(" #n ")" ::: "memory")
#define PG8_WAIT_L(n) asm volatile("s_waitcnt lgkmcnt(" #n ")" ::: "memory")
#define PG8_BAR __builtin_amdgcn_s_barrier()
#define PG8_SCHED __builtin_amdgcn_sched_barrier(0)
    Unit cur, nxt; int ui = 0;
    if (!S.next(0, cur)) return;
    Acc acc;
#pragma unroll
    for (int a = 0; a < 2; ++a)
#pragma unroll
        for (int b = 0; b < 2; ++b)
#pragma unroll
            for (int m = 0; m < 4; ++m)
#pragma unroll
                for (int n = 0; n < 2; ++n) acc[a][b][m][n] = (f32x4){0.f, 0.f, 0.f, 0.f};
    bf16x8 At[4][2], B0[2][2], B1[2][2];
    unsigned oa[2][2], na[2][2];
    S.aoff(cur, R, Cb, oa);
    const char* cA = cur.A; const char* cB = cur.B;
    PG8_STAGE_B(PG8_SB(0, 0), cB); PG8_STAGE_B(PG8_SB(0, 1), cB + hstep); PG8_STAGE_A(PG8_SA(0, 0), cA, oa[0][0], oa[0][1]); PG8_STAGE_A(PG8_SA(0, 1), cA, oa[1][0], oa[1][1]);
    if (wr == 1) PG8_BAR;
    PG8_WAIT_V(2); PG8_BAR;
    PG8_STAGE_B(PG8_SB(1, 0), cB + kstep); PG8_STAGE_A(PG8_SA(1, 0), cA + kstep, oa[0][0], oa[0][1]); PG8_STAGE_B(PG8_SB(1, 1), cB + hstep + kstep);
    PG8_WAIT_V(6); PG8_BAR;
    for (;;) {
        const bool has_next = S.next(ui + 1, nxt);
        if (has_next) S.aoff(nxt, R, Cb, na);
        else {
#pragma unroll
            for (int h = 0; h < 2; ++h)
#pragma unroll
                for (int i = 0; i < 2; ++i) na[h][i] = oa[h][i];
        }
        const char* nA = has_next ? nxt.A : cA; const char* nB = has_next ? nxt.B : cB;
        for (int t = 0; t < nt; t += 2) {
            const bool last = (t == nt - 2);
            const char* a1 = cA + (size_t)(t + 1) * kstep;
            const char* a2 = last ? nA : cA + (size_t)(t + 2) * kstep; const char* b2 = last ? nB : cB + (size_t)(t + 2) * kstep;
            const char* a3 = a2 + kstep; const char* b3 = b2 + kstep;
            const unsigned p00 = last ? na[0][0] : oa[0][0], p01 = last ? na[0][1] : oa[0][1], p10 = last ? na[1][0] : oa[1][0], p11 = last ? na[1][1] : oa[1][1];
            PG8_LDB(B0, 0, 0); PG8_LDB(B1, 0, 1); PG8_SCHED; PG8_LDA(At, 0, 0); PG8_STAGE_A(PG8_SA(1, 1), a1, oa[1][0], oa[1][1]);
            PG8_WAIT_V(8); PG8_WAIT_L(0); PG8_BAR; PG8_MMA(0, 0, At, B0); PG8_MMA(0, 1, At, B1); PG8_BAR; PG8_SCHED;
            PG8_LDA(At, 0, 1); PG8_STAGE_B(PG8_SB(0, 0), b2); PG8_STAGE_B(PG8_SB(0, 1), b2 + hstep); PG8_STAGE_A(PG8_SA(0, 0), a2, p00, p01);
            PG8_WAIT_V(8); PG8_WAIT_L(0); PG8_BAR; PG8_MMA(1, 0, At, B0); PG8_MMA(1, 1, At, B1); PG8_BAR; PG8_SCHED;
            PG8_LDB(B0, 1, 0); PG8_LDB(B1, 1, 1); PG8_SCHED; PG8_LDA(At, 1, 0); PG8_STAGE_A(PG8_SA(0, 1), a2, p10, p11);
            PG8_WAIT_V(8); PG8_WAIT_L(0); PG8_BAR; PG8_MMA(0, 0, At, B0); PG8_MMA(0, 1, At, B1); PG8_BAR; PG8_SCHED;
            PG8_LDA(At, 1, 1); PG8_STAGE_B(PG8_SB(1, 0), b3); PG8_STAGE_B(PG8_SB(1, 1), b3 + hstep); PG8_STAGE_A(PG8_SA(1, 0), a3, p00, p01);
            PG8_WAIT_V(8); PG8_WAIT_L(0); PG8_BAR; PG8_MMA(1, 0, At, B0); PG8_MMA(1, 1, At, B1); PG8_BAR; PG8_SCHED;
        }
        if constexpr (ALIGN_EPI) { if (wr == 0) PG8_BAR; }
        E(acc, cur, wr, wc, fr, fq);
        if (!has_next) break;
        if (!Epi::keep(cur)) {
#pragma unroll
        for (int a = 0; a < 2; ++a)
#pragma unroll
            for (int b = 0; b < 2; ++b)
#pragma unroll
                for (int m = 0; m < 4; ++m)
#pragma unroll
                    for (int n = 0; n < 2; ++n) acc[a][b][m][n] = (f32x4){0.f, 0.f, 0.f, 0.f};
        }
        cur = nxt; cA = nA; cB = nB; ++ui;
#pragma unroll
        for (int h = 0; h < 2; ++h)
#pragma unroll
            for (int i = 0; i < 2; ++i) oa[h][i] = na[h][i];
        if constexpr (ALIGN_EPI) { if (wr == 1) PG8_BAR; }
    }
    PG8_WAIT_V(0);
    if constexpr (!ALIGN_EPI) { if (wr == 0) PG8_BAR; }
    PG8_BAR;
#undef PG8_SA
#undef PG8_SB
#undef PG8_STAGE_A
#undef PG8_STAGE_B
#undef PG8_LDA
#undef PG8_LDB
#undef PG8_MMA
#undef PG8_WAIT_V
#undef PG8_WAIT_L
#undef PG8_BAR
#undef PG8_SCHED
}
template <class Epi, class Sched, bool ALIGN_EPI>
__device__ __forceinline__ void gemm_phase8(PG8_LAS unsigned char* lds, const int K, const Sched& S, const Epi& E) {
    const int tid = threadIdx.x, wid = __builtin_amdgcn_readfirstlane(tid >> 6), lane = tid & 63, wr = wid >> 2, wc = wid & 3, fr = lane & 15, fq = lane >> 4;
    const int nt = K / BK;
    int R[2], Cb[2]; unsigned voffB[2];
#pragma unroll
    for (int i = 0; i < 2; ++i) { int R_, C_; stage_rc(tid * 16 + i * 8192, R_, C_); const int Rb = Epi::PERM ? ((R_ & ~31) + perm32(R_ & 31)) : R_;
        R[i] = R_; Cb[i] = C_ * 2; voffB[i] = (unsigned)(Rb * K + C_) * 2u; }
    const size_t kstep = (size_t)(BK * 2);
    const size_t hstep = (size_t)HALF * K * 2;
    const unsigned ldsw = (unsigned)wid * 1024u;
    const int aoffl = lds_byte(wr * 64 + fr, fq * 16), boffl = lds_byte(wc * 32 + fr, fq * 16);
#define PG8_SA(b, h) (((b) * 2 + (h)) * HTB)
#define PG8_SB(b, h) ((4 + (b) * 2 + (h)) * HTB)
#define PG8_STAGE_B(bufoff, gbase) do { _Pragma("unroll") for (int _i = 0; _i < 2; ++_i) \
        __builtin_amdgcn_global_load_lds((const unsigned*)((const char*)(gbase) + voffB[_i]), (PG8_LAS unsigned*)(lds + (bufoff) + ldsw + _i * 8192), 16, 0, 0); } while (0)
#define PG8_STAGE_A(bufoff, gbase, o0, o1) do { \
        __builtin_amdgcn_global_load_lds((const unsigned*)((const char*)(gbase) + (o0)), (PG8_LAS unsigned*)(lds + (bufoff) + ldsw), 16, 0, 0); \
        __builtin_amdgcn_global_load_lds((const unsigned*)((const char*)(gbase) + (o1)), (PG8_LAS unsigned*)(lds + (bufoff) + ldsw + 8192), 16, 0, 0); } while (0)
#define PG8_LD32(p) __builtin_bit_cast(v8i, __builtin_shufflevector(*(const PG8_LAS bf16x8*)(p), *(const PG8_LAS bf16x8*)((p) + 16), 0, 1, 2, 3, 4, 5, 6, 7, 8, 9, 10, 11, 12, 13, 14, 15))
#define PG8_LDA(dst, b, h) do { _Pragma("unroll") for (int m = 0; m < 4; ++m) dst[m] = PG8_LD32(lds + PG8_SA(b, h) + aoffl + m * 2048); } while (0)
#define PG8_LDB(dst, b, h) do { _Pragma("unroll") for (int n = 0; n < 2; ++n) dst[n] = PG8_LD32(lds + PG8_SB(b, h) + boffl + n * 2048); } while (0)
#define PG8_MMA(ai, bj, At, Bt) do { __builtin_amdgcn_s_setprio(1); _Pragma("unroll") for (int m = 0; m < 4; ++m) _Pragma("unroll") for (int n = 0; n < 2; ++n) \
        asm volatile("v_mfma_f32_16x16x128_f8f6f4 %0, %1, %2, %0" : "+v"(acc[ai][bj][m][n]) : "v"(Bt[n]), "v"(At[m])); __builtin_amdgcn_s_setprio(0); } while (0)
#define PG8_WAIT_V(n) asm volatile("s_waitcnt vmcnt(" #n ")" ::: "memory")
#define PG8_WAIT_L(n) asm volatile("s_waitcnt lgkmcnt(" #n ")" ::: "memory")
#define PG8_BAR __builtin_amdgcn_s_barrier()
#define PG8_SCHED __builtin_amdgcn_sched_barrier(0)
    Unit cur, nxt; int ui = 0;
    if (!S.next(0, cur)) return;
    Acc acc;
#pragma unroll
    for (int a = 0; a < 2; ++a)
#pragma unroll
        for (int b = 0; b < 2; ++b)
#pragma unroll
            for (int m = 0; m < 4; ++m)
#pragma unroll
                for (int n = 0; n < 2; ++n) acc[a][b][m][n] = (f32x4){0.f, 0.f, 0.f, 0.f};
    v8i At[4], B0[2], B1[2];
    unsigned oa[2][2], na[2][2];
    S.aoff(cur, R, Cb, oa);
    typename Epi::Pre pre = E.pre(cur, wc, fq);
    const char* cA = cur.A; const char* cB = cur.B;
    PG8_STAGE_B(PG8_SB(0, 0), cB); PG8_STAGE_B(PG8_SB(0, 1), cB + hstep); PG8_STAGE_A(PG8_SA(0, 0), cA, oa[0][0], oa[0][1]); PG8_STAGE_A(PG8_SA(0, 1), cA, oa[1][0], oa[1][1]);
    if (wr == 1) PG8_BAR;
    PG8_WAIT_V(2); PG8_BAR;
    PG8_STAGE_B(PG8_SB(1, 0), cB + kstep); PG8_STAGE_A(PG8_SA(1, 0), cA + kstep, oa[0][0], oa[0][1]); PG8_STAGE_B(PG8_SB(1, 1), cB + hstep + kstep);
    PG8_WAIT_V(6); PG8_BAR;
    for (;;) {
        const bool has_next = S.next(ui + 1, nxt);
        if (has_next) S.aoff(nxt, R, Cb, na);
        else {
#pragma unroll
            for (int h = 0; h < 2; ++h)
#pragma unroll
                for (int i = 0; i < 2; ++i) na[h][i] = oa[h][i];
        }
        const char* nA = has_next ? nxt.A : cA; const char* nB = has_next ? nxt.B : cB;
#pragma unroll 1
        for (int t = 0; t < nt; t += 2) {
            const bool last = (t == nt - 2);
            const char* a1 = cA + (size_t)(t + 1) * kstep;
            const char* a2 = last ? nA : cA + (size_t)(t + 2) * kstep; const char* b2 = last ? nB : cB + (size_t)(t + 2) * kstep;
            const char* a3 = a2 + kstep; const char* b3 = b2 + kstep;
            const unsigned p00 = last ? na[0][0] : oa[0][0], p01 = last ? na[0][1] : oa[0][1], p10 = last ? na[1][0] : oa[1][0], p11 = last ? na[1][1] : oa[1][1];
            PG8_LDB(B0, 0, 0); PG8_LDB(B1, 0, 1); PG8_SCHED; PG8_LDA(At, 0, 0); PG8_STAGE_A(PG8_SA(1, 1), a1, oa[1][0], oa[1][1]);
            PG8_WAIT_V(8); PG8_WAIT_L(0); PG8_BAR; PG8_MMA(0, 0, At, B0); PG8_MMA(0, 1, At, B1); PG8_BAR; PG8_SCHED;
            PG8_LDA(At, 0, 1); PG8_STAGE_B(PG8_SB(0, 0), b2); PG8_STAGE_B(PG8_SB(0, 1), b2 + hstep); PG8_STAGE_A(PG8_SA(0, 0), a2, p00, p01);
            PG8_WAIT_V(8); PG8_WAIT_L(0); PG8_BAR; PG8_MMA(1, 0, At, B0); PG8_MMA(1, 1, At, B1); PG8_BAR; PG8_SCHED;
            PG8_LDB(B0, 1, 0); PG8_LDB(B1, 1, 1); PG8_SCHED; PG8_LDA(At, 1, 0); PG8_STAGE_A(PG8_SA(0, 1), a2, p10, p11);
            PG8_WAIT_V(8); PG8_WAIT_L(0); PG8_BAR; PG8_MMA(0, 0, At, B0); PG8_MMA(0, 1, At, B1); PG8_BAR; PG8_SCHED;
            PG8_LDA(At, 1, 1); PG8_STAGE_B(PG8_SB(1, 0), b3); PG8_STAGE_B(PG8_SB(1, 1), b3 + hstep); PG8_STAGE_A(PG8_SA(1, 0), a3, p00, p01);
            PG8_WAIT_V(8); PG8_WAIT_L(0); PG8_BAR; PG8_MMA(1, 0, At, B0); PG8_MMA(1, 1, At, B1); PG8_BAR; PG8_SCHED;
        }
        if constexpr (ALIGN_EPI) { if (wr == 0) PG8_BAR; }
        asm volatile("s_nop 15\n\ts_nop 7" ::: "memory");
        E(acc, cur, pre, wr, wc, fr, fq);
        if (!has_next) break;
#pragma unroll
        for (int a = 0; a < 2; ++a)
#pragma unroll
            for (int b = 0; b < 2; ++b)
#pragma unroll
                for (int m = 0; m < 4; ++m)
#pragma unroll
                    for (int n = 0; n < 2; ++n) acc[a][b][m][n] = (f32x4){0.f, 0.f, 0.f, 0.f};
        cur = nxt; cA = nA; cB = nB; ++ui; pre = E.pre(cur, wc, fq);
#pragma unroll
        for (int h = 0; h < 2; ++h)
#pragma unroll
            for (int i = 0; i < 2; ++i) oa[h][i] = na[h][i];
        if constexpr (ALIGN_EPI) { if (wr == 1) PG8_BAR; }
    }
    PG8_WAIT_V(0);
    if constexpr (!ALIGN_EPI) { if (wr == 0) PG8_BAR; }
    PG8_BAR;
#undef PG8_SA
#undef PG8_SB
#undef PG8_STAGE_A
#undef PG8_STAGE_B
#undef PG8_LD32
#undef PG8_LDA
#undef PG8_LDB
#undef PG8_MMA
#undef PG8_WAIT_V
#undef PG8_WAIT_L
#undef PG8_BAR
#undef PG8_SCHED
}
}
namespace attn_body {
using bf16=__hip_bfloat16;
using bf16x8=__attribute__((ext_vector_type(8)))short;
using s16x4=__attribute__((ext_vector_type(4)))short;
using f32x16=__attribute__((ext_vector_type(16)))float;
using u32x4=__attribute__((ext_vector_type(4)))unsigned;
constexpr int BATCH=2,NHEAD=8,SEQ=8192,D=64,DM=NHEAD*D;
constexpr int NW=8,QBLK=32,QB=QBLK*NW,KVBLK=64,NQB=SEQ/QB;
constexpr int ATTN_PITCH=DM, ATTN_UNIT_ROWS=QB;
__device__ __forceinline__ int crow(int r,int hi){return (r&3)+8*(r>>2)+4*hi;}
#define SBAR() __builtin_amdgcn_sched_barrier(0)
__device__ __forceinline__ void cmask(f32x16&p0,f32x16&p1,int jb,int qrel,int hi){
  const float NEG=-INFINITY; int kb=64*jb+4*hi;
  #pragma unroll
  for(int r=0;r<16;++r){int kv=kb+(r&3)+8*(r>>2); if(kv>qrel)p0[r]=NEG; if(kv+32>qrel)p1[r]=NEG;}
}

constexpr int NSLOT=3, SLOTB=8192;
constexpr int LDS_K=0, LDS_V=NSLOT*SLOTB, LDS_WS=2*NSLOT*SLOTB, LDS_OST=LDS_WS+NW*64*4, LDS_KX=LDS_OST+NW*4096, LDS_BYTES=LDS_KX+NSLOT*1024;
constexpr float C2=0.125f*1.4426950408889634f;
__device__ __forceinline__ void glds16(const void*gsrc,unsigned lds_dst){unsigned keep;
  asm volatile("s_mov_b32 %0, m0\n\ts_mov_b32 m0, %2\n\ts_nop 0\n\tglobal_load_lds_dwordx4 %1, off\n\ts_mov_b32 m0, %0":"=&s"(keep):"v"(gsrc),"s"(lds_dst):"memory");}
__device__ __forceinline__ float max3f(float a,float b,float c){float r;asm("v_max3_f32 %0, %1, %2, %3":"=v"(r):"v"(a),"v"(b),"v"(c));return r;}
__device__ __forceinline__ float max2f(float a,float b){float r;asm("v_max_f32_e32 %0, %1, %2":"=v"(r):"v"(a),"v"(b));return r;}
__device__ __forceinline__ float fadd_s(float a,float b){float r;asm("v_add_f32_e32 %0, %1, %2":"=v"(r):"v"(a),"v"(b));return r;}
__device__ __forceinline__ float fsub_s(float a,float b){float r;asm("v_sub_f32_e32 %0, %1, %2":"=v"(r):"v"(a),"v"(b));return r;}
typedef float f32x2_t __attribute__((ext_vector_type(2))); typedef __bf16 bf16x2_t __attribute__((ext_vector_type(2)));
__device__ __forceinline__ unsigned cvtpk_s(float lo,float hi){f32x2_t v={lo,hi};bf16x2_t b=__builtin_convertvector(v,bf16x2_t);return __builtin_bit_cast(unsigned,b);}
#define WAIT_BAR(N) asm volatile("s_waitcnt vmcnt(" #N ") lgkmcnt(0)\n\ts_barrier":::"memory")

typedef unsigned u32x2_t __attribute__((ext_vector_type(2)));
#define KXFRAG(w) __builtin_bit_cast(bf16x8,(u32x4){(w)[0],(w)[1],0x0000BF80u,0u})
__device__ __forceinline__ void qkt(f32x16&p0,f32x16&p1,const char*Kslot,const char*KXslot,const bf16x8*qr,const bf16x8 qxf,int r32,int hi){
  const char*kb=Kslot+hi*1024+r32*16;
  const f32x16 z16=f32x16{};
  #pragma unroll
  for(int d0=0;d0<4;++d0){
    const bf16x8 b0=*reinterpret_cast<const bf16x8*>(kb+d0*2048);
    const bf16x8 b1=*reinterpret_cast<const bf16x8*>(kb+d0*2048+512);
    if(d0==0){p0=__builtin_amdgcn_mfma_f32_32x32x16_bf16(b0,qr[0],z16,0,0,0);p1=__builtin_amdgcn_mfma_f32_32x32x16_bf16(b1,qr[0],z16,0,0,0);}
    else{p0=__builtin_amdgcn_mfma_f32_32x32x16_bf16(b0,qr[d0],p0,0,0,0);p1=__builtin_amdgcn_mfma_f32_32x32x16_bf16(b1,qr[d0],p1,0,0,0);}}
  const u32x2_t w0=*reinterpret_cast<const u32x2_t*>(KXslot+r32*8), w1=*reinterpret_cast<const u32x2_t*>(KXslot+r32*8+256);
  p0=__builtin_amdgcn_mfma_f32_32x32x16_bf16(KXFRAG(w0),qxf,p0,0,0,0);p1=__builtin_amdgcn_mfma_f32_32x32x16_bf16(KXFRAG(w1),qxf,p1,0,0,0);
}
typedef __attribute__((address_space(3))) const char* lds_cptr;
typedef short v4i16_t __attribute__((ext_vector_type(4)));
__device__ __forceinline__ void kload8(bf16x8*kf,lds_cptr kp){
  kf[0]=*(const __attribute__((address_space(3))) bf16x8*)(kp);      kf[1]=*(const __attribute__((address_space(3))) bf16x8*)(kp+512);
  kf[2]=*(const __attribute__((address_space(3))) bf16x8*)(kp+2048); kf[3]=*(const __attribute__((address_space(3))) bf16x8*)(kp+2560);
  kf[4]=*(const __attribute__((address_space(3))) bf16x8*)(kp+4096); kf[5]=*(const __attribute__((address_space(3))) bf16x8*)(kp+4608);
  kf[6]=*(const __attribute__((address_space(3))) bf16x8*)(kp+6144); kf[7]=*(const __attribute__((address_space(3))) bf16x8*)(kp+6656);
}
__device__ __forceinline__ void kload2(bf16x8*kf,lds_cptr kp,int j){ kf[2*j]=*(const __attribute__((address_space(3))) bf16x8*)(kp+j*2048); kf[2*j+1]=*(const __attribute__((address_space(3))) bf16x8*)(kp+j*2048+512); }
__device__ __forceinline__ s16x4 vtr(lds_cptr p){ return __builtin_bit_cast(s16x4,__builtin_amdgcn_ds_read_tr16_b64_v4i16((__attribute__((address_space(3))) v4i16_t*)p)); }
__device__ __forceinline__ float rowmax(const f32x16&p0,const f32x16&p1){
  float a=max3f(p0[0],p0[1],p1[0]),b=max3f(p0[2],p0[3],p1[1]);a=max3f(a,p1[2],p1[3]);
  #pragma unroll
  for(int r=4;r<16;r+=4){a=max3f(a,p0[r],p0[r+1]);b=max3f(b,p0[r+2],p0[r+3]);a=max3f(a,p1[r],p1[r+1]);b=max3f(b,p1[r+2],p1[r+3]);}
  const float m=max2f(a,b);
  auto rr=__builtin_amdgcn_permlane32_swap(__float_as_uint(m),__float_as_uint(m),false,false);
  return max2f(__uint_as_float(rr[0]),__uint_as_float(rr[1]));
}
__device__ __forceinline__ void pv(f32x16*o,int vb,bf16x8 pa0,bf16x8 pa1,bf16x8 pa2,bf16x8 pa3){
  #pragma unroll
  for(int d0=0;d0<2;++d0){s16x4 lo[4],hi[4];
    #pragma unroll
    for(int ks=0;ks<4;++ks){
      asm volatile("ds_read_b64_tr_b16 %0,%1 offset:%c2":"=&v"(lo[ks]):"v"(vb),"i"(d0*4096+ks*1024):"memory");
      asm volatile("ds_read_b64_tr_b16 %0,%1 offset:%c2":"=&v"(hi[ks]):"v"(vb),"i"(d0*4096+ks*1024+512):"memory");}
    asm volatile("s_waitcnt lgkmcnt(0)":::"memory");SBAR();
    #define PK(k) (bf16x8){lo[k][0],lo[k][1],lo[k][2],lo[k][3],hi[k][0],hi[k][1],hi[k][2],hi[k][3]}
    o[d0]=__builtin_amdgcn_mfma_f32_32x32x16_bf16(pa0,PK(0),o[d0],0,0,0);
    o[d0]=__builtin_amdgcn_mfma_f32_32x32x16_bf16(pa1,PK(1),o[d0],0,0,0);
    o[d0]=__builtin_amdgcn_mfma_f32_32x32x16_bf16(pa2,PK(2),o[d0],0,0,0);
    o[d0]=__builtin_amdgcn_mfma_f32_32x32x16_bf16(pa3,PK(3),o[d0],0,0,0);
    #undef PK
  }
}

#ifndef ATTN_STORE16
#define ATTN_STORE16(p,v) (*(u32x4*)(p)=(v))
#endif
template<int THRL> __device__ __forceinline__ void attn_unit(int b,int h,int qb,int NTE,const bf16*Q,const bf16*__restrict__ K,const bf16*__restrict__ V,const unsigned*__restrict__ KX,bf16*O,char*shm){
  const int tid=threadIdx.x,lane=tid&63,r32=lane&31,hi=lane>>5; const int wid=__builtin_amdgcn_readfirstlane(tid>>6);
  const long rowbase=(long)b*SEQ; const int q0=qb*QB;
  const bf16*Qw=Q+(rowbase+q0+wid*QBLK)*DM+h*D;
  const bf16*Kh=K+rowbase*DM+h*D,*Vh=V+rowbase*DM+h*D;
  const unsigned lds0=(unsigned)(uintptr_t)shm;
  float*wsf=(float*)(shm+LDS_WS)+wid*64;
  const bf16*ksrc=Kh+(long)lane*DM+wid*8;
  const bf16*vsrc=Vh+(long)(16*(wid&3)+(lane>>2))*DM+(wid>>2)*32+(lane&3)*8;
  const unsigned kdst=lds0+LDS_K+wid*1024, vdst=lds0+LDS_V+wid*1024, kxdst=lds0+LDS_KX;
  const char*kxsrc=(const char*)KX+((long)(b*NHEAD+h)*SEQ)*8+(lane&31)*16;
  #define TILE(t) (((t)<4)?(NT-4+(t)):(NT-1-(t)))
  #define DMA_K(t,slot) glds16(ksrc+(long)TILE(t)*KVBLK*DM,(unsigned)__builtin_amdgcn_readfirstlane(kdst+(slot)))
  #define DMA_V(t,slot) glds16(vsrc+(long)TILE(t)*KVBLK*DM,(unsigned)__builtin_amdgcn_readfirstlane(vdst+(slot)))
  #define DMA_KX(t,slot) do{ if(wid==0) glds16(kxsrc+(long)TILE(t)*KVBLK*8,(unsigned)__builtin_amdgcn_readfirstlane(kxdst+((slot)>>3))); }while(0)
  const int vb0=(int)(lds0+LDS_V)+((lane>>4)&1)*32+(lane&3)*8+(4*hi+((lane&15)>>2))*64;
  const char*Kbase=shm+LDS_K; bf16x8 kf[8];
  const lds_cptr shm3=(lds_cptr)shm; const lds_cptr kxp0=shm3+LDS_KX+r32*8; const lds_cptr kp0=shm3+LDS_K+hi*1024+r32*16; const lds_cptr vp0=shm3+LDS_V+((lane>>4)&1)*32+(lane&3)*8+(4*hi+((lane&15)>>2))*64;
  const int NT=(q0+QB)/KVBLK;
  DMA_KX(0,0);DMA_KX(1,SLOTB);DMA_KX(2,2*SLOTB);
  DMA_K(0,0);DMA_V(0,0);DMA_K(1,SLOTB);
  bf16x8 qr[4];
  #pragma unroll
  for(int d0=0;d0<4;++d0)qr[d0]=*reinterpret_cast<const bf16x8*>(&Qw[(long)r32*DM+d0*16+hi*8]);
  float mhat=0.f,l_reg=0.f;f32x16 o[2];o[0]=f32x16{};o[1]=f32x16{};
  unsigned qx0=hi?0u:0x3F803F80u,qx1=hi?0u:0x00003F80u,qx2=0u;
  u32x2_t kxw0,kxw1;
  #define QXF __builtin_bit_cast(bf16x8,(u32x4){qx0,qx1,qx2,0u})
  #define SETREF(DL,DLE) do{ const float tgt_=mhat+(DL); const unsigned ph_=cvtpk_s(tgt_,0.f)&0xffffu; const float fh_=__uint_as_float(ph_<<16); \
    const unsigned pl_=cvtpk_s(tgt_-fh_,0.f)&0xffffu; const float mnew_=fh_+__uint_as_float(pl_<<16); DLE=mnew_-mhat; mhat=mnew_; \
    qx1=hi?0u:(0x3F80u|(ph_<<16)); qx2=hi?0u:pl_; }while(0)
  const int qrel=wid*QBLK+r32;
  #define CMASK(P0,P1,t) do{ if((t)<4)cmask(P0,P1,(t),qrel,hi); }while(0)
  bool resc=false;
  #define START(P0,P1) do{ const float rm=rowmax(P0,P1); resc=false; \
    { float dl; SETREF(rm,dl); \
      _Pragma("unroll") for(int r=0;r<16;++r){P0[r]=fsub_s(P0[r],dl);P1[r]=fsub_s(P1[r],dl);} } \
    _Pragma("unroll") for(int r=0;r<16;++r)P0[r]=__builtin_amdgcn_exp2f(P0[r]); }while(0)
  #define RESC() do{ if(resc){ asm volatile("s_waitcnt lgkmcnt(0)":::"memory"); \
      _Pragma("unroll") for(int d_=0;d_<2;++d_) _Pragma("unroll") for(int r=0;r<16;++r)o[d_][r]*=wsf[crow(r,hi)]; } }while(0)
  f32x16 pA0,pA1,pB0,pB1;
  int sl_prev=0,sl_cur=0,sl_next=SLOTB;
  #define ROT() do{sl_prev=sl_cur;sl_cur=sl_next;sl_next=(sl_next==(NSLOT-1)*SLOTB)?0:sl_next+SLOTB;}while(0)
  DMA_K(2,2*SLOTB);
  WAIT_BAR(3);
  qkt(pA0,pA1,Kbase,shm+LDS_KX,qr,QXF,r32,hi);asm volatile("s_nop 15\n\ts_nop 7":"+v"(pA0),"+v"(pA1));CMASK(pA0,pA1,0);
  START(pA0,pA1);
  _Pragma("unroll") for(int r=0;r<16;++r)pA1[r]=__builtin_amdgcn_exp2f(pA1[r]);
  WAIT_BAR(0);
  DMA_KX(3,0);DMA_K(3,0);DMA_V(1,SLOTB);
  ROT();
  kload8(kf,kp0+sl_cur); kxw0=*(const __attribute__((address_space(3))) u32x2_t*)(kxp0+(sl_cur>>3)); kxw1=*(const __attribute__((address_space(3))) u32x2_t*)(kxp0+(sl_cur>>3)+256);
  WAIT_BAR(2);
  s16x4 vlo[8],vhi[8]; u32x4 pw0,pw1,pw2,pw3;
  #define PKW(P,B) cvtpk_s(P[B],P[B+1])
  #define PAF(k) __builtin_bit_cast(bf16x8,pw##k)
  #define VFR(i) (bf16x8){vlo[i][0],vlo[i][1],vlo[i][2],vlo[i][3],vhi[i][0],vhi[i][1],vhi[i][2],vhi[i][3]}
  #define PIN(x) asm volatile("":"+v"(x))
  #define MX3(a,b,c) __builtin_fmaxf(__builtin_fmaxf((a),(b)),(c))
  #define GAPA(MF,A0,A1,A2,A3,W0,W1,PW) do{ MF; sacc+=A0; sacc+=A1; sacc+=A2; sacc+=A3; PIN(sacc); W0; W1; PIN(PW); SBAR(); }while(0)
  #define EX(v) __builtin_amdgcn_exp2f(v)
  #define GAPB(MF,X,B) do{ MF; X[B]=EX(X[B]); X[B+1]=EX(X[B+1]); X[B+2]=EX(X[B+2]); X[B+3]=EX(X[B+3]); PIN(X); SBAR(); }while(0)
  #define VRD(i) do{ vlo[i]=vtr(vp_+(((i)>>2)*4096+((i)&3)*1024)); vhi[i]=vtr(vp_+(((i)>>2)*4096+((i)&3)*1024+512)); }while(0)
  #define KRD(G,j) do{ if(G){ kload2(kf,kp0+sl_next,j); SBAR(); } }while(0)
  #define KXRD(G) do{ if(G){ kxw0=*(const __attribute__((address_space(3))) u32x2_t*)(kxp0+(sl_next>>3)); kxw1=*(const __attribute__((address_space(3))) u32x2_t*)(kxp0+(sl_next>>3)+256); SBAR(); } }while(0)
  #define STEP(C0,C1,P0,P1,t,GK,GV,GL) do{ SBAR(); \
    const lds_cptr vp_=vp0+sl_prev; const f32x16 z16_=f32x16{}; const bf16x8 qxf_=QXF; \
    VRD(0); SBAR(); float sacc=(P0[0]+P0[1]); \
    GAPA(C0=__builtin_amdgcn_mfma_f32_32x32x16_bf16(kf[0],qr[0],z16_,0,0,0), P0[2],P0[3],P0[4],P0[5],     pw0[0]=PKW(P0,0), pw0[1]=PKW(P0,2), pw0); \
    VRD(4); SBAR(); GAPA(C1=__builtin_amdgcn_mfma_f32_32x32x16_bf16(kf[1],qr[0],z16_,0,0,0), P0[6],P0[7],P0[8],P0[9],     pw0[2]=PKW(P0,4), pw0[3]=PKW(P0,6), pw0); \
    VRD(1); SBAR(); GAPA(C0=__builtin_amdgcn_mfma_f32_32x32x16_bf16(kf[2],qr[1],C0,0,0,0),   P0[10],P0[11],P0[12],P0[13], pw1[0]=PKW(P0,8), pw1[1]=PKW(P0,10), pw1); \
    VRD(5); SBAR(); GAPA(C1=__builtin_amdgcn_mfma_f32_32x32x16_bf16(kf[3],qr[1],C1,0,0,0),   P0[14],P0[15],P1[0],P1[1],   pw1[2]=PKW(P0,12),pw1[3]=PKW(P0,14), pw1); \
    VRD(2); SBAR(); GAPA(C0=__builtin_amdgcn_mfma_f32_32x32x16_bf16(kf[4],qr[2],C0,0,0,0),   P1[2],P1[3],P1[4],P1[5],     pw2[0]=PKW(P1,0), pw2[1]=PKW(P1,2), pw2); \
    VRD(6); SBAR(); GAPA(C1=__builtin_amdgcn_mfma_f32_32x32x16_bf16(kf[5],qr[2],C1,0,0,0),   P1[6],P1[7],P1[8],P1[9],     pw2[2]=PKW(P1,4), pw2[3]=PKW(P1,6), pw2); \
    VRD(3); SBAR(); GAPA(C0=__builtin_amdgcn_mfma_f32_32x32x16_bf16(kf[6],qr[3],C0,0,0,0),   P1[10],P1[11],P1[12],P1[13], pw3[0]=PKW(P1,8), pw3[1]=PKW(P1,10), pw3); \
    VRD(7); SBAR(); GAPA(C1=__builtin_amdgcn_mfma_f32_32x32x16_bf16(kf[7],qr[3],C1,0,0,0),   P1[14],P1[15],0.f,0.f,       pw3[2]=PKW(P1,12),pw3[3]=PKW(P1,14), pw3); \
    C0=__builtin_amdgcn_mfma_f32_32x32x16_bf16(KXFRAG(kxw0),qxf_,C0,0,0,0); SBAR(); C1=__builtin_amdgcn_mfma_f32_32x32x16_bf16(KXFRAG(kxw1),qxf_,C1,0,0,0); SBAR(); \
    l_reg+=sacc; \
    if(GK){DMA_KX((t)+3,sl_cur);DMA_K((t)+3,sl_cur);} if(GV){DMA_V((t)+1,sl_next);} \
    CMASK(C0,C1,t); \
    { float a=MX3(C0[0],C0[1],C1[0]),b=MX3(C0[2],C0[3],C1[1]); a=MX3(a,C1[2],C1[3]); \
      _Pragma("unroll") for(int r=4;r<16;r+=4){a=MX3(a,C0[r],C0[r+1]);b=MX3(b,C0[r+2],C0[r+3]);a=MX3(a,C1[r],C1[r+1]);b=MX3(b,C1[r+2],C1[r+3]);} \
      float rm=__builtin_fmaxf(a,b); { auto rr=__builtin_amdgcn_permlane32_swap(__float_as_uint(rm),__float_as_uint(rm),false,false); rm=__builtin_fmaxf(__uint_as_float(rr[0]),__uint_as_float(rr[1])); } \
      resc=false; \
      if(__builtin_expect(__any(rm>(float)THRL),0)){ float dl; SETREF(__builtin_fmaxf(rm,0.f),dl); \
        _Pragma("unroll") for(int r=0;r<16;++r){C0[r]-=dl;C1[r]-=dl;} \
        const float f=__builtin_amdgcn_exp2f(-dl); l_reg*=f; if(hi==0)wsf[r32]=f; resc=true; } } \
    SBAR(); \
    GAPB(o[0]=__builtin_amdgcn_mfma_f32_32x32x16_bf16(PAF(0),VFR(0),o[0],0,0,0), C0,0); \
    GAPB(o[1]=__builtin_amdgcn_mfma_f32_32x32x16_bf16(PAF(0),VFR(4),o[1],0,0,0), C0,4); \
    KXRD(GL); KRD(GL,0); GAPB(o[0]=__builtin_amdgcn_mfma_f32_32x32x16_bf16(PAF(1),VFR(1),o[0],0,0,0), C0,8); \
    KRD(GL,1); GAPB(o[1]=__builtin_amdgcn_mfma_f32_32x32x16_bf16(PAF(1),VFR(5),o[1],0,0,0), C0,12); \
    KRD(GL,2); GAPB(o[0]=__builtin_amdgcn_mfma_f32_32x32x16_bf16(PAF(2),VFR(2),o[0],0,0,0), C1,0); \
    KRD(GL,3); GAPB(o[1]=__builtin_amdgcn_mfma_f32_32x32x16_bf16(PAF(2),VFR(6),o[1],0,0,0), C1,4); \
    GAPB(o[0]=__builtin_amdgcn_mfma_f32_32x32x16_bf16(PAF(3),VFR(3),o[0],0,0,0), C1,8); \
    GAPB(o[1]=__builtin_amdgcn_mfma_f32_32x32x16_bf16(PAF(3),VFR(7),o[1],0,0,0), C1,12); \
    }while(0)
  int t=1;
  #define ENDW(tt) do{ if((tt)+3<NTE){WAIT_BAR(2);} else if((tt)+2<NTE){WAIT_BAR(1);} else {WAIT_BAR(0);} }while(0)
  for(;t+1<NTE;t+=2){
    if(t>=5){
      #undef CMASK
      #define CMASK(P0,P1,t) do{}while(0)
      for(;t+5<NTE;t+=2){
        STEP(pB0,pB1,pA0,pA1,t,true,true,true);     WAIT_BAR(2); RESC(); ROT();
        STEP(pA0,pA1,pB0,pB1,t+1,true,true,true);   WAIT_BAR(2); RESC(); ROT();
      }
      #undef CMASK
      #define CMASK(P0,P1,t) do{ if((t)<4)cmask(P0,P1,(t),qrel,hi); }while(0)
      if(!(t+1<NTE))break;
    }
    STEP(pB0,pB1,pA0,pA1,t,(t+3<NTE),(t+1<NTE),(t+1<NTE));       ENDW(t);   RESC(); ROT();
    STEP(pA0,pA1,pB0,pB1,t+1,(t+4<NTE),(t+2<NTE),(t+2<NTE));     ENDW(t+1); RESC(); ROT();
  }
  STEP(pB0,pB1,pA0,pA1,NTE-1,false,false,false); RESC();
  { float sacc=pB0[0]+pB0[1]; _Pragma("unroll") for(int r=2;r<16;++r)sacc+=pB0[r]; _Pragma("unroll") for(int r=0;r<16;++r)sacc+=pB1[r]; l_reg+=sacc;
    pw0=(u32x4){PKW(pB0,0),PKW(pB0,2),PKW(pB0,4),PKW(pB0,6)};pw1=(u32x4){PKW(pB0,8),PKW(pB0,10),PKW(pB0,12),PKW(pB0,14)};pw2=(u32x4){PKW(pB1,0),PKW(pB1,2),PKW(pB1,4),PKW(pB1,6)};pw3=(u32x4){PKW(pB1,8),PKW(pB1,10),PKW(pB1,12),PKW(pB1,14)};
    SBAR(); pv(o,vb0+sl_cur,PAF(0),PAF(1),PAF(2),PAF(3)); }
  #undef PKW
  #undef PAF
  #undef VFR
  #undef PIN
  #undef MX3
  #undef GAPA
  #undef GAPB
  #undef EX
  #undef VRD
  #undef KRD
  #undef KXRD
  #undef STEP
  #undef ENDW
  {auto rr=__builtin_amdgcn_permlane32_swap(__float_as_uint(l_reg),__float_as_uint(l_reg),false,false);l_reg=__uint_as_float(rr[0])+__uint_as_float(rr[1]);}
  if(hi==0)wsf[32+r32]=l_reg;asm volatile("s_waitcnt lgkmcnt(0)":::"memory");
  float rli[16];
  #pragma unroll
  for(int r=0;r<16;++r)rli[r]=__builtin_amdgcn_rcpf(wsf[32+crow(r,hi)]);
  bf16*Ow=O+(rowbase+q0+wid*QBLK)*DM+h*D;
  { bf16*stg=(bf16*)(shm+LDS_OST)+wid*2048;
    #pragma unroll
    for(int r=0;r<16;++r){const int orow=crow(r,hi);
      #pragma unroll
      for(int d0=0;d0<2;++d0)stg[orow*64+d0*32+r32]=__float2bfloat16(o[d0][r]*rli[r]);}
    asm volatile("s_waitcnt lgkmcnt(0)":::"memory");
    #pragma unroll
    for(int i=0;i<4;++i){const int row=i*8+(lane>>3),ch=lane&7; const u32x4 v=*(const u32x4*)(stg+row*64+ch*8); ATTN_STORE16(Ow+(long)row*DM+ch*8,v);} }
  asm volatile("s_waitcnt lgkmcnt(0)\n\ts_barrier":::"memory");
  #undef DMA_K
  #undef DMA_V
  #undef DMA_KX
  #undef TILE
  #undef QXF
  #undef SETREF
  #undef CMASK
  #undef START
  #undef RESC
  #undef ROT
}
constexpr int ATTN_LDS_BYTES=LDS_BYTES;
struct AttnTensors { const bf16* Q; const bf16* K; const bf16* V; const unsigned* KX; bf16* O; };
struct AttnUnit { int bh; int qb; };
struct AttnQueue { unsigned* ctr; const float* BIAS; const float* NORM; int nunits; };
template<int THRL=8> __device__ __forceinline__ void attn_phase(char*lds,volatile __attribute__((address_space(3))) unsigned* bc,const AttnTensors&T,const AttnQueue&Qu){
  const int lane=threadIdx.x&63;
  for(;;){
    if(threadIdx.x==0) bc[0]=__hip_atomic_fetch_add(Qu.ctr,1u,__ATOMIC_RELAXED,__HIP_MEMORY_SCOPE_AGENT);
    __syncthreads();
    const int u=(int)bc[0];
    if(u>=Qu.nunits)break;
    const int uu=u&511, bh=uu&15, qb=31-(uu>>4), NT=4*qb+4;
    const float pq=Qu.NORM[bh*2], pk=Qu.NORM[bh*2+1];
    const float thr=153.f+4.08f*sqrtf(pq*pk);
    const float* B=Qu.BIAS+(long)bh*SEQ; const float b0=B[qb*QB];
    const bool n0=(lane<NT)&&!(b0-B[64*lane+63]>thr), n1=(lane+64<NT)&&!(b0-B[64*(lane+64)+63]>thr);
    const unsigned long long m0=__ballot(n0), m1=__ballot(n1);
    int alo=m0?(int)__builtin_ctzll(m0):(m1?64+(int)__builtin_ctzll(m1):NT);
    if(alo>NT-4)alo=NT-4;
    int nx=NT-4-alo; nx+=nx&1;
    attn_unit<THRL>(bh/NHEAD,bh%NHEAD,qb,4+nx,T.Q,T.K,T.V,T.KX,T.O,lds);
  }
}
#undef SBAR
#undef WAIT_BAR
}
constexpr int NWAVES = 8;
#ifndef MK_N_LAUNCHES
#define MK_N_LAUNCHES 1
#endif
constexpr int NPH = 11;
constexpr int BATCH = 2, SEQ = 8192, D = 1024, T = BATCH * SEQ, NH = 8, HD = 64, AW = 512, CW = 512, CK = 31, NE = 32, TOPK = 4, DE = 1024, NMOD = 6, INC = 4616, NIN = 4608, OFF_F = 2560;
constexpr int SLOTS_MAX = T * TOPK + NE * 256, TILES_MAX = SLOTS_MAX / 256;
constexpr float RMS_EPS = 1e-5f, LN_EPS = 1e-5f, LOG2E = 1.4426950408889634f;
constexpr size_t MiB = 1u << 20;
constexpr size_t WS_CTL = 0, CTL_ZERO_BYTES = 64 * 1024;
constexpr size_t WS_MOD = 1 * MiB;
constexpr size_t WS_LF = WS_MOD + 256 * 1024;
constexpr size_t WS_KX = 2 * MiB;
constexpr size_t WS_WRT = 5 * MiB + 512 * 1024;
constexpr size_t WS_BIAS = 5 * MiB;
constexpr size_t CTL_NORM = 40960, CTL_QCTR = 40960 + 256, CTL_CVT = 40960 + 512, CTL_DONE = 40960 + 1024;
constexpr size_t WS_HIST = 3 * MiB;
constexpr size_t WS_TOPE = WS_HIST + 256 * 1024, WS_TOPG = WS_TOPE + 256 * 1024, WS_LRANK = WS_TOPG + 256 * 1024;
constexpr size_t WS_SLOT_TOK = 4 * MiB, WS_TOK_SLOT = WS_SLOT_TOK + 512 * 1024, WS_TILE_E = WS_TOK_SLOT + 256 * 1024;
constexpr size_t WS_WIN = 6 * MiB;
constexpr size_t WS_WC = 15 * MiB, WS_WA = 16 * MiB, WS_WO = 17 * MiB;
constexpr size_t WS_W1 = 20 * MiB;
constexpr size_t WS_W2 = 148 * MiB;
constexpr size_t WS_H = 212 * MiB;
constexpr size_t WS_AGLU = 244 * MiB, WS_Q = 260 * MiB, WS_K = 276 * MiB, WS_V = 292 * MiB;
constexpr size_t WS_SGC = 308 * MiB, WS_SGA = 340 * MiB;
constexpr size_t WS_ALN = 372 * MiB, WS_ATT = 388 * MiB;
constexpr size_t WS_MIX = 404 * MiB;
constexpr size_t WS_X1 = 436 * MiB;
constexpr size_t WS_HM = 500 * MiB;
constexpr size_t WS_YB = 644 * MiB;
constexpr size_t WS_END = 788 * MiB;
constexpr int CW_BAR = 1024;
constexpr int RING_BYTES = 131072;
constexpr int LDSCTL_OFF = RING_BYTES, MISC_OFF = LDSCTL_OFF + 320;
constexpr int ROWTAB_OFF = RING_BYTES + 1024, ROWTAB_UNITS = 12;
constexpr int LDS_BYTES = 147456;
static_assert(ROWTAB_OFF + ROWTAB_UNITS * 1024 <= LDS_BYTES, "LDS map");

#define GAS __attribute__((address_space(1)))
#define LAS __attribute__((address_space(3)))
typedef unsigned short bf16;
typedef unsigned v4u __attribute__((ext_vector_type(4)));
typedef unsigned v2u __attribute__((ext_vector_type(2)));
typedef float f32x4 __attribute__((ext_vector_type(4)));
typedef GAS unsigned gu32;
#define RLX_AGENT __ATOMIC_RELAXED, __HIP_MEMORY_SCOPE_AGENT
#define LDS_WAIT() asm volatile("s_waitcnt lgkmcnt(0)" ::: "memory")
#define VM_WAIT() asm volatile("s_waitcnt vmcnt(0)" ::: "memory")
__device__ __forceinline__ unsigned pk2(float lo, float hi) { return pg8::cvt_pk_bf16(lo, hi); }
__device__ __forceinline__ int fresh_lane() { int l; asm volatile("v_mbcnt_lo_u32_b32 %0, -1, 0\n\tv_mbcnt_hi_u32_b32 %0, -1, %0" : "=v"(l)); return l; }
__device__ __forceinline__ float wave_sum(float v) {
    v += __builtin_bit_cast(float, __builtin_amdgcn_update_dpp(0, __builtin_bit_cast(int, v), 0xB1, 0xF, 0xF, false));
    v += __builtin_bit_cast(float, __builtin_amdgcn_update_dpp(0, __builtin_bit_cast(int, v), 0x4E, 0xF, 0xF, false));
    v += __builtin_bit_cast(float, __builtin_amdgcn_update_dpp(0, __builtin_bit_cast(int, v), 0x141, 0xF, 0xF, false));
    v += __builtin_bit_cast(float, __builtin_amdgcn_update_dpp(0, __builtin_bit_cast(int, v), 0x140, 0xF, 0xF, false));
    v += __builtin_bit_cast(float, __builtin_amdgcn_update_dpp(0, __builtin_bit_cast(int, v), 0x142, 0xA, 0xF, false));
    v += __builtin_bit_cast(float, __builtin_amdgcn_update_dpp(0, __builtin_bit_cast(int, v), 0x143, 0xC, 0xF, false));
    return __builtin_bit_cast(float, __builtin_amdgcn_readlane(__builtin_bit_cast(int, v), 63));
}

#define XB_TMO      128
#define XB_XCNT(j)  (256  + 64 * (j))
#define XB_XSUB(j)  (1280 + 64 * (j))
#define XB_XGEN(j)  (2304 + 64 * (j))
#define XB_TOP      3328
#define XB_TOPGEN   3392
#define XCD_BAR_WORDS 3456
#define XB_SPIN_CAP (1u << 18)
__device__ __forceinline__ unsigned xb_ld(unsigned* p)              { return __hip_atomic_load(p, __ATOMIC_RELAXED, __HIP_MEMORY_SCOPE_AGENT); }
__device__ __forceinline__ unsigned xb_add(unsigned* p, unsigned v) { return __hip_atomic_fetch_add(p, v, __ATOMIC_RELAXED, __HIP_MEMORY_SCOPE_AGENT); }
__device__ __forceinline__ unsigned xb_xcc_id() { return (unsigned)__builtin_amdgcn_s_getreg((3 << 11) | 20) & 0xFu; }
#define XB_SPIN(cond, bar) do { unsigned _sp = 0; while (cond) { __builtin_amdgcn_s_sleep(1); \
    if ((++_sp & 255u) == 0u) { if (xb_ld(&(bar)[XB_TMO])) break; if (_sp > XB_SPIN_CAP) { atomicAdd(&(bar)[XB_TMO], 1u); break; } } } } while (0)
struct XcdBarrier { unsigned* bar; unsigned x; volatile LAS unsigned* st; };
__device__ __forceinline__ XcdBarrier xcd_barrier_post(unsigned* bar, volatile LAS unsigned* st) {
    XcdBarrier b; b.bar = bar; b.x = xb_xcc_id(); b.st = st;
    if (threadIdx.x == 0) (void)xb_add(&bar[XB_XCNT(b.x)], 1u);
    return b;
}
__device__ __forceinline__ void xcd_barrier_complete(unsigned* bar, unsigned x, unsigned& nloc, unsigned& nx) {
    const unsigned G = gridDim.x * gridDim.y * gridDim.z;
    unsigned sum, cnt, mine, sp = 0u;
    for (;;) {
        sum = 0u; cnt = 0u; mine = 0u;
#pragma unroll
        for (unsigned j = 0; j < 16; ++j) { const unsigned c = xb_ld(&bar[XB_XCNT(j)]); sum += c; cnt += (c > 0u) ? 1u : 0u; mine = (j == x) ? c : mine; }
        if (sum == G) break;
        __builtin_amdgcn_s_sleep(1);
        if ((++sp & 255u) == 0u) { if (xb_ld(&bar[XB_TMO])) break; if (sp > XB_SPIN_CAP) { atomicAdd(&bar[XB_TMO], 1u); break; } }
    }
    nloc = mine > 0u ? mine : 1u; nx = cnt > 0u ? cnt : 1u;
}
__device__ __forceinline__ void xcd_barrier(const XcdBarrier& b) {
    asm volatile("s_waitcnt vmcnt(0)" ::: "memory");
    __syncthreads();
    if (threadIdx.x == 0) {
        unsigned* bar = b.bar;
        __builtin_amdgcn_s_waitcnt(0);
        unsigned nloc = b.st[0], nx = b.st[1];
        if (nloc == 0u) { xcd_barrier_complete(bar, b.x, nloc, nx); b.st[0] = nloc; b.st[1] = nx; }
        const unsigned old = xb_add(&bar[XB_XSUB(b.x)], 1u);
        const unsigned gen = old / nloc;
        if (old + 1u == (gen + 1u) * nloc) {
            __builtin_amdgcn_fence(__ATOMIC_RELEASE, "agent");
            asm volatile("s_waitcnt vmcnt(0)" ::: "memory");
            const unsigned og = xb_add(&bar[XB_TOP], 1u);
            const unsigned tg = og / nx;
            if (og + 1u == (tg + 1u) * nx) xb_add(&bar[XB_TOPGEN], 1u);
            else XB_SPIN(xb_ld(&bar[XB_TOPGEN]) == tg, bar);
            __builtin_amdgcn_fence(__ATOMIC_ACQUIRE, "agent");
            xb_add(&bar[XB_XGEN(b.x)], 1u);
            asm volatile("s_waitcnt vmcnt(0)" ::: "memory");
        } else {
            XB_SPIN(xb_ld(&bar[XB_XGEN(b.x)]) == gen, bar);
            __builtin_amdgcn_fence(__ATOMIC_ACQUIRE, "agent");
            asm volatile("s_waitcnt vmcnt(0)" ::: "memory");
        }
    }
    __syncthreads();
}

struct Args { const float* in[22]; float* out; unsigned char* ws; int ph_lo, ph_hi; };

struct Frame {
    LAS unsigned char* lds; int tid, lane, wave, vcu, G; unsigned char* ws;
};

__device__ __forceinline__ void p0_mod(Frame& F, const float* c, const float* w_ada, const float* b_ada, float* mod) {
    LAS float* sc = (LAS float*)F.lds;
    LAS float* red = sc + 2048;
    for (int i = F.tid; i < 2048; i += NWAVES * 64) { const float v = c[i]; sc[i] = v * pg8::sigm(v); }
    __syncthreads();
    for (int item = F.vcu; item < (NMOD * D) / 24; item += F.G) {
        const int n0 = item * 24, col = F.tid % 24, kp = F.tid / 24;
        if (kp < 21) {
            float a0 = 0.f, a1 = 0.f;
            float wv[49];
#pragma unroll
            for (int j = 0; j < 49; ++j) { const int k = kp + 21 * j; wv[j] = (k < D) ? __builtin_nontemporal_load(w_ada + (size_t)k * (NMOD * D) + n0 + col) : 0.f; }
#pragma unroll
            for (int j = 0; j < 49; ++j) { const int k = kp + 21 * j; if (k < D) { a0 += sc[k] * wv[j]; a1 += sc[1024 + k] * wv[j]; } }
            red[kp * 24 + col] = a0; red[504 + kp * 24 + col] = a1;
        }
        __syncthreads();
        if (F.tid < 48) { const int b = F.tid / 24, cc = F.tid % 24; float s = 0.f;
            for (int j = 0; j < 21; ++j) s += red[b * 504 + j * 24 + cc];
            mod[b * (NMOD * D) + n0 + cc] = s + b_ada[n0 + cc]; }
        __syncthreads();
    }
}
__device__ __forceinline__ void tr_item(const float* W, int ldw, int col0, int k0, bf16* WT, int Kd, int drow0, LAS float* scr, int lane) {
    float v[32];
#pragma unroll
    for (int i = 0; i < 32; ++i) { const int kk = 2 * i + (lane >> 5); v[i] = W[(size_t)(k0 + kk) * ldw + col0 + (lane & 31)]; }
#pragma unroll
    for (int i = 0; i < 32; ++i) { const int kk = 2 * i + (lane >> 5); scr[kk * 33 + (lane & 31)] = v[i]; }
    LDS_WAIT(); asm volatile("" ::: "memory");
    const int c = lane & 7;
#pragma unroll
    for (int j = 0; j < 4; ++j) { const int n = (lane >> 3) + 8 * j; const LAS float* s = scr + (8 * c) * 33 + n;
        v4u o; o.x = pk2(s[0 * 33], s[1 * 33]); o.y = pk2(s[2 * 33], s[3 * 33]); o.z = pk2(s[4 * 33], s[5 * 33]); o.w = pk2(s[6 * 33], s[7 * 33]);
        *(GAS v4u*)(WT + (size_t)(drow0 + n) * Kd + k0 + 8 * c) = o; }
    LDS_WAIT(); asm volatile("" ::: "memory");
}
__device__ __forceinline__ void tr8_load(float (&v)[32], const float* W, int ldw, int col0, int k0, int lane) {
    const unsigned loff = (unsigned)((lane >> 5) * ldw + (lane & 31));
    const unsigned long long b0 = (unsigned long long)(W + (size_t)k0 * ldw + col0);
    const unsigned blo = (unsigned)__builtin_amdgcn_readfirstlane((int)(unsigned)b0), bhi = (unsigned)__builtin_amdgcn_readfirstlane((int)(unsigned)(b0 >> 32));
    const unsigned long long bs = ((unsigned long long)bhi << 32) | blo;
    const unsigned step = (unsigned)__builtin_amdgcn_readfirstlane(ldw * 8);
#pragma unroll
    for (int i = 0; i < 32; ++i) { const GAS float* rowp = (const GAS float*)(bs + (unsigned long long)i * step); v[i] = __builtin_nontemporal_load(rowp + loff);   }
}
__device__ __forceinline__ void tr8_finish(const float (&v)[32], int k0, unsigned char* WT, int Kd, int drow0, LAS float* scr, int lane) {
#pragma unroll
    for (int i = 0; i < 32; ++i) { const int kk = 2 * i + (lane >> 5); scr[kk * 33 + (lane & 31)] = v[i] * 32.f; }
    LDS_WAIT(); asm volatile("" ::: "memory");
    const int n = lane & 31, kh = lane >> 5; const LAS float* sp = scr + (32 * kh) * 33 + n;
    v4u o0, o1;
    o0.x = pg8::pk4_fp8(sp[0 * 33], sp[1 * 33], sp[2 * 33], sp[3 * 33]);     o0.y = pg8::pk4_fp8(sp[4 * 33], sp[5 * 33], sp[6 * 33], sp[7 * 33]);
    o0.z = pg8::pk4_fp8(sp[8 * 33], sp[9 * 33], sp[10 * 33], sp[11 * 33]);   o0.w = pg8::pk4_fp8(sp[12 * 33], sp[13 * 33], sp[14 * 33], sp[15 * 33]);
    o1.x = pg8::pk4_fp8(sp[16 * 33], sp[17 * 33], sp[18 * 33], sp[19 * 33]); o1.y = pg8::pk4_fp8(sp[20 * 33], sp[21 * 33], sp[22 * 33], sp[23 * 33]);
    o1.z = pg8::pk4_fp8(sp[24 * 33], sp[25 * 33], sp[26 * 33], sp[27 * 33]); o1.w = pg8::pk4_fp8(sp[28 * 33], sp[29 * 33], sp[30 * 33], sp[31 * 33]);
    GAS v4u* dst = (GAS v4u*)(WT + (size_t)(drow0 + n) * Kd + k0 + 32 * kh);
    dst[0] = o0; dst[1] = o1;
    LDS_WAIT(); asm volatile("" ::: "memory");
}
__device__ __forceinline__ void tr_item8(const float* W, int ldw, int col0, int k0, unsigned char* WT, int Kd, int drow0, LAS float* scr, int lane) {
    float v[32]; tr8_load(v, W, ldw, col0, k0, lane); tr8_finish(v, k0, WT, Kd, drow0, scr, lane);
}
__device__ __forceinline__ void p0_router_w(Frame& F, const float* w_router) {
    bf16* WRT = (bf16*)(F.ws + WS_WRT);
    for (int i = F.vcu * NWAVES * 64 + F.tid; i < NE * D; i += F.G * NWAVES * 64) { const int e = i >> 10, k = i & 1023; const float w = w_router[(size_t)k * NE + e];
        const unsigned h = pk2(w, 0.f) & 0xffffu; const float fh = __builtin_bit_cast(float, h << 16); const unsigned lo = pk2(w - fh, 0.f) & 0xffffu;
        WRT[i] = (bf16)h; WRT[NE * D + i] = (bf16)lo; }
}
__device__ __forceinline__ void p0_convert(Frame& F, const float* w_in, const float* w_conv_out, const float* w_attn_out, const float* w_out, const float* w_exp_in, const float* w_exp_out) {
    LAS float* scr = (LAS float*)(F.lds + 16384 + F.wave * 12288);
    bf16* WIN = (bf16*)(F.ws + WS_WIN); bf16* WC = (bf16*)(F.ws + WS_WC); bf16* WA = (bf16*)(F.ws + WS_WA); bf16* WO = (bf16*)(F.ws + WS_WO); bf16* W1 = (bf16*)(F.ws + WS_W1); bf16* W2 = (bf16*)(F.ws + WS_W2);
    const int gw = F.vcu * NWAVES + F.wave, NGW = F.G * NWAVES;
    constexpr int I_IN = 16 * 144, I_C = 8 * 32, I_O = 16 * 32;
    constexpr int NITEMS = I_IN + 2 * I_C + I_O;
    for (int it = gw; it < NITEMS; it += NGW) {
        int r = it;
        if (r < I_IN) { const int kb = r / 144, db = r % 144; int src;
            if (db < 32) { const int tile = db >> 3, w = db & 7; src = (w < 4) ? 128 * tile + 32 * w : 512 + 128 * tile + 32 * (w - 4); }
            else if (db < 80) src = 32 * db; else src = 32 * db + 8;
            tr_item8(w_in, INC, src, 64 * kb, (unsigned char*)WIN, D, 32 * db, scr, F.lane); continue; } r -= I_IN;
        if (r < I_C) { tr_item(w_conv_out, D, 32 * (r % 32), 64 * (r / 32), WC, CW, 32 * (r % 32), scr, F.lane); continue; } r -= I_C;
        if (r < I_C) { tr_item(w_attn_out, D, 32 * (r % 32), 64 * (r / 32), WA, AW, 32 * (r % 32), scr, F.lane); continue; } r -= I_C;
        tr_item(w_out, D, 32 * (r % 32), 64 * (r / 32), WO, D, 32 * (r % 32), scr, F.lane);
    }
}
#ifndef CVT_FILL_WAVES
#define CVT_FILL_WAVES 8
#endif
constexpr int CVT_I1 = 16 * 64 * NE, CVT_I2 = 16 * 32 * NE, CVT_ITEMS = CVT_I1 + CVT_I2;
struct CvtItem { const float* W; unsigned char* WT; int ldw, col0, k0, Kd, drow0; };
__device__ __forceinline__ CvtItem cvt_item(Frame& F, const float* w_exp_in, const float* w_exp_out, int r) {
    unsigned char* W1 = (unsigned char*)(F.ws + WS_W1); unsigned char* W2 = (unsigned char*)(F.ws + WS_W2);
    CvtItem c;
    if (r < CVT_I1) { const int e = r / 1024, qq = r % 1024, cq = qq >> 4, jj = qq & 15, kb = 2 * (cq & 7) + (jj & 1), db = 8 * (cq >> 3) + (jj >> 1), tile = db >> 3, w = db & 7; const int src = (w < 4) ? 128 * tile + 32 * w : 1024 + 128 * tile + 32 * (w - 4);
        c.W = w_exp_in + (size_t)e * D * 2 * DE; c.ldw = 2 * DE; c.col0 = src; c.k0 = 64 * kb; c.WT = W1 + (size_t)e * 2 * DE * D; c.Kd = D; c.drow0 = 32 * db; }
    else { r -= CVT_I1; const int e = r / 512, qq = r % 512, cq = qq >> 4, jj = qq & 15, kb = 2 * (cq & 7) + (jj & 1), nb = 8 * (cq >> 3) + (jj >> 1);
        c.W = w_exp_out + (size_t)e * DE * D; c.ldw = D; c.col0 = 32 * nb; c.k0 = 64 * kb; c.WT = W2 + (size_t)e * D * DE; c.Kd = DE; c.drow0 = 32 * nb; }
    return c;
}
constexpr int CVT_CHUNK = 16, CVT_EARLY = 12;
__device__ __forceinline__ int cvt_claim(volatile LAS unsigned* misc, gu32* ctr, int lane) {
    for (;;) {
        const unsigned w = misc[10];
        if (w == 0xFFFFFFFFu) return -1;
        const unsigned used = w & 63u;
        if (w != 0u && used < (unsigned)CVT_CHUNK) {
            unsigned seen = w;
            if (lane == 0) { unsigned exp = w; (void)__hip_atomic_compare_exchange_strong((LAS unsigned*)(misc + 10), &exp, w + 1u, __ATOMIC_RELAXED, __ATOMIC_RELAXED, __HIP_MEMORY_SCOPE_WORKGROUP); seen = exp; }
            seen = (unsigned)__builtin_amdgcn_readfirstlane((int)seen);
            if (seen == w) return (int)((w >> 6) - 1u + used);
            continue;
        }
        unsigned lk = 1u;
        if (lane == 0) { unsigned exp = 0u; (void)__hip_atomic_compare_exchange_strong((LAS unsigned*)(misc + 11), &exp, 1u, __ATOMIC_RELAXED, __ATOMIC_RELAXED, __HIP_MEMORY_SCOPE_WORKGROUP); lk = exp; }
        lk = (unsigned)__builtin_amdgcn_readfirstlane((int)lk);
        if (lk == 0u) {
            if (misc[10] == w) {
                unsigned it = 0; if (lane == 0) it = __hip_atomic_fetch_add(ctr, (unsigned)CVT_CHUNK, RLX_AGENT);
                it = (unsigned)__builtin_amdgcn_readfirstlane((int)it);
                misc[10] = (it >= (unsigned)CVT_ITEMS) ? 0xFFFFFFFFu : ((it + 1u) << 6);
            }
            LDS_WAIT(); misc[11] = 0u; LDS_WAIT();
        } else __builtin_amdgcn_s_sleep(2);
    }
}
__device__ __forceinline__ void cvt_fill(Frame& F, const float* w_exp_in, const float* w_exp_out, int phase_tag, volatile LAS unsigned* misc) {
    LAS float* scr = (LAS float*)(F.lds + F.wave * 12288);
    gu32* ctr = (gu32*)(F.ws + WS_CTL + CTL_CVT); gu32* done = (gu32*)(F.ws + WS_CTL + CTL_DONE) + 64 * phase_tag;
    const int lane = fresh_lane();
    if (phase_tag && F.wave >= CVT_FILL_WAVES) return;
    auto stop = [&]() -> bool {
        if (!phase_tag) return false;
        if (F.wave == 0) { if ((unsigned)__builtin_amdgcn_readfirstlane((int)__hip_atomic_load(done, RLX_AGENT)) >= (unsigned)(F.G - CVT_EARLY)) misc[2] = (unsigned)phase_tag; }
        return misc[2] == (unsigned)phase_tag;
    };
    if (stop()) return;
    int r = cvt_claim(misc, ctr, lane);
    if (r < 0) return;
    float v[32]; { const CvtItem c = cvt_item(F, w_exp_in, w_exp_out, r); tr8_load(v, c.W, c.ldw, c.col0, c.k0, lane); }
    for (;;) {
        const int r2 = stop() ? -1 : cvt_claim(misc, ctr, lane);
        float w[32];
        if (r2 >= 0) { const CvtItem c = cvt_item(F, w_exp_in, w_exp_out, r2); tr8_load(w, c.W, c.ldw, c.col0, c.k0, lane); }
        { const CvtItem c = cvt_item(F, w_exp_in, w_exp_out, r); tr8_finish(v, c.k0, c.WT, c.Kd, c.drow0, scr, lane); }
        if (r2 < 0) break;
#pragma unroll
        for (int i = 0; i < 32; ++i) v[i] = w[i];
        r = r2;
    }
}
__device__ __forceinline__ void phase_main_done(Frame& F, int phase_tag) {
    if (F.tid == 0) (void)__hip_atomic_fetch_add((gu32*)(F.ws + WS_CTL + CTL_DONE) + 64 * phase_tag, 1u, RLX_AGENT);
}
__device__ __forceinline__ float log_sigmoid_f(float x) { return fminf(x, 0.f) - log1pf(expf(-fabsf(x))); }
__device__ __forceinline__ void p1_stage_wf(Frame& F, const float* w_in) {
    LAS f32x4* wf = (LAS f32x4*)F.lds;
    for (int i = F.tid; i < 2048; i += NWAVES * 64) { const int k = i >> 1, h4 = i & 1; const int j = k >> 8, l = (k & 255) >> 2, c = k & 3;
        wf[((j * 4 + c) * 2 + h4) * 64 + l] = *(const f32x4*)(w_in + (size_t)k * INC + OFF_F + 4 * h4); }
}
__device__ __forceinline__ void p1_norm1(Frame& F, const float* x, const float* g, const float* mod, const float* w_in, const float* b_forget, bool staged, const f32x4 (&pre)[4]) {
    LAS f32x4* wf = (LAS f32x4*)F.lds;
    if (!staged) { p1_stage_wf(F, w_in); __syncthreads(); }
    bf16* H = (bf16*)(F.ws + WS_H); float* LF = (float*)(F.ws + WS_LF);
    const int gw = F.vcu * NWAVES + F.wave, NGW = F.G * NWAVES, l = F.lane;
    const float bfl = b_forget[l & 7];
    constexpr int RPW = 8;
    for (int m0 = gw * RPW; m0 < T; m0 += NGW * RPW) {
        const int b = m0 / SEQ;
        const float* sh = mod + (size_t)b * NMOD * D; const float* sc = sh + D;
        f32x4 gs[4], s0[4];
#pragma unroll
        for (int j = 0; j < 4; ++j) { const int k0 = 256 * j + 4 * l; gs[j] = *(const f32x4*)(g + k0) * (*(const f32x4*)(sc + k0) + 1.f); s0[j] = *(const f32x4*)(sh + k0); }
        f32x4 nx[4];
#pragma unroll
        for (int j = 0; j < 4; ++j) nx[j] = (staged && m0 == gw * RPW) ? pre[j] : __builtin_nontemporal_load((const f32x4*)(x + (size_t)m0 * D + 256 * j + 4 * l));
#pragma unroll 1
        for (int i = 0; i < RPW; ++i) {
            const int m = m0 + i, t = m % SEQ;
            f32x4 v[4]; float ss = 0.f;
#pragma unroll
            for (int j = 0; j < 4; ++j) { v[j] = nx[j]; ss += (v[j].x * v[j].x + v[j].y * v[j].y) + (v[j].z * v[j].z + v[j].w * v[j].w); }
            if (i + 1 < RPW) {
#pragma unroll
                for (int j = 0; j < 4; ++j) nx[j] = __builtin_nontemporal_load((const f32x4*)(x + (size_t)(m + 1) * D + 256 * j + 4 * l));
            }
            const float rstd = rsqrtf(wave_sum(ss) * (1.f / D) + RMS_EPS);
            float fl[8];
#pragma unroll
            for (int hh = 0; hh < 8; ++hh) fl[hh] = 0.f;
#pragma unroll
            for (int j = 0; j < 4; ++j) { f32x4 hv = v[j] * rstd * gs[j] + s0[j]; v[j] = hv;
#pragma unroll
                for (int c = 0; c < 4; ++c) { const f32x4 w0 = wf[((j * 4 + c) * 2 + 0) * 64 + l], w1 = wf[((j * 4 + c) * 2 + 1) * 64 + l]; const float hc = hv[c];
                    fl[0] += hc * w0.x; fl[1] += hc * w0.y; fl[2] += hc * w0.z; fl[3] += hc * w0.w; fl[4] += hc * w1.x; fl[5] += hc * w1.y; fl[6] += hc * w1.z; fl[7] += hc * w1.w; } }
            GAS unsigned* o4 = (GAS unsigned*)((unsigned char*)H + (size_t)m * D) + l;
#pragma unroll
            for (int j = 0; j < 4; ++j) o4[64 * j] = pg8::pk4_fp8(v[j].x, v[j].y, v[j].z, v[j].w);
            float mine = 0.f;
#pragma unroll
            for (int hh = 0; hh < 8; ++hh) { const float s = wave_sum(fl[hh]); mine = ((l & 7) == hh) ? s : mine; }
            const float ls = log_sigmoid_f(mine + bfl);
            if (l < 8) LF[(size_t)(b * NH + l) * SEQ + t] = ls;
        }
    }
    __syncthreads();
}
__device__ __forceinline__ void p2_fscan(Frame& F, int bh) {
    LAS double* part = (LAS double*)F.lds;
    const float* LF = (const float*)(F.ws + WS_LF) + (size_t)bh * SEQ; v2u* KX = (v2u*)(F.ws + WS_KX) + (size_t)bh * SEQ; float* BIAS = (float*)(F.ws + WS_BIAS) + (size_t)bh * SEQ;
    const int i = F.tid;
    double loc[16]; double run = 0.0;
#pragma unroll
    for (int q = 0; q < 4; ++q) { const f32x4 v = *(const f32x4*)(LF + i * 16 + 4 * q);
        run += (double)v.x; loc[4 * q] = run; run += (double)v.y; loc[4 * q + 1] = run; run += (double)v.z; loc[4 * q + 2] = run; run += (double)v.w; loc[4 * q + 3] = run; }
    part[i] = run; __syncthreads();
    for (int o = 1; o < 512; o <<= 1) { const double pv = (i >= o) ? part[i - o] : 0.0; __syncthreads(); part[i] += pv; __syncthreads(); }
    const double base = (i > 0) ? part[i - 1] : 0.0;
#pragma unroll
    for (int j = 0; j < 16; ++j) { const float bias = (float)(-(base + loc[j]) * 1.4426950408889634);
        const unsigned ph = pk2(bias, 0.f) & 0xffffu; const float fh = __builtin_bit_cast(float, ph << 16);
        const float r1 = bias - fh; const unsigned pm = pk2(r1, 0.f) & 0xffffu; const float fm = __builtin_bit_cast(float, pm << 16);
        const unsigned pl = pk2(r1 - fm, 0.f) & 0xffffu;
        v2u o; o.x = ph | (pm << 16); o.y = pl | 0xBF800000u; KX[i * 16 + j] = o; BIAS[i * 16 + j] = bias; }
    __syncthreads();
}
__device__ __forceinline__ f32x4 ld4bf(const bf16* p) { const v2u w = *(const v2u*)p; return (f32x4){pg8::bf_lo(w.x), pg8::bf_hi(w.x), pg8::bf_lo(w.y), pg8::bf_hi(w.y)}; }
__device__ __forceinline__ float dppf(float v, const int ctrl_tag) {
    const int x = __builtin_bit_cast(int, v);
    return __builtin_bit_cast(float, ctrl_tag == 0 ? __builtin_amdgcn_update_dpp(0, x, 0xB1, 0xF, 0xF, false) : ctrl_tag == 1 ? __builtin_amdgcn_update_dpp(0, x, 0x4E, 0xF, 0xF, false)
                                   : ctrl_tag == 2 ? __builtin_amdgcn_update_dpp(0, x, 0x141, 0xF, 0xF, false) : __builtin_amdgcn_update_dpp(0, x, 0x140, 0xF, 0xF, false));
}
__device__ __forceinline__ int dppi(int x, const int ctrl_tag) {
    return ctrl_tag == 0 ? __builtin_amdgcn_update_dpp(0, x, 0xB1, 0xF, 0xF, false) : ctrl_tag == 1 ? __builtin_amdgcn_update_dpp(0, x, 0x4E, 0xF, 0xF, false)
         : ctrl_tag == 2 ? __builtin_amdgcn_update_dpp(0, x, 0x141, 0xF, 0xF, false) : __builtin_amdgcn_update_dpp(0, x, 0x140, 0xF, 0xF, false);
}
template <int N, int SZ> __device__ __forceinline__ void tr_step(float (&v)[SZ], int l) {
    if constexpr (N == 32 || N == 16) {
        const bool up = (l & N) != 0;
#pragma unroll
        for (int i = 0; i < N; ++i) { const float a = v[i], bb = v[i + N]; const float mine = up ? bb : a, other = up ? a : bb; v[i] = mine + __shfl_xor(other, N); }
    } else {
        const bool up = (l & N) != 0; constexpr int tag = (N == 8) ? 3 : (N == 4) ? 2 : (N == 2) ? 1 : 0;
#pragma unroll
        for (int i = 0; i < N; ++i) { const float a = v[i], bb = v[i + N]; const float mine = up ? bb : a, other = up ? a : bb; v[i] = mine + dppf(other, tag); }
    }
}
__device__ __forceinline__ float dot2c(float acc, unsigned a, unsigned b) { asm("v_dot2c_f32_bf16 %0, %1, %2" : "+v"(acc) : "v"(a), "v"(b)); return acc; }
__device__ __forceinline__ void p3_conv(Frame& F, const float* conv_w, const float* conv_b, const float* ln_g, const float* ln_b, volatile LAS unsigned* misc, int nrep) {
    LAS float* part = (LAS float*)F.lds;
    LAS unsigned short* ain = (LAS unsigned short*)(F.lds + 4096);
    LAS unsigned short* aout = (LAS unsigned short*)(F.lds + 4096 + 62 * 1024);
    const bf16* AGLU = (const bf16*)(F.ws + WS_AGLU); bf16* ALN = (bf16*)(F.ws + WS_ALN);
    const int l = fresh_lane(), c = 64 * F.wave + l;
    unsigned wE[16], wO[16];
    { float w[31];
#pragma unroll
      for (int j = 0; j < CK; ++j) w[j] = conv_w[j * CW + c];
#pragma unroll
      for (int q = 0; q < 15; ++q) wE[q] = pk2(w[2 * q], w[2 * q + 1]);
      wE[15] = pk2(w[30], 0.f); wO[0] = pk2(0.f, w[0]);
#pragma unroll
      for (int q = 1; q < 16; ++q) wO[q] = pk2(w[2 * q - 1], w[2 * q]); }
    const float cb = conv_b[c], lg = ln_g[c], lb = ln_b[c];
    gu32* qc = (gu32*)(F.ws + WS_CTL + CTL_QCTR) + 1;
    for (;;) {
        __syncthreads();
        if (F.tid == 0) misc[1] = __hip_atomic_fetch_add(qc, 1u, RLX_AGENT);
        __syncthreads();
        const int it_ = (int)misc[1]; if (it_ >= nrep * (T / 32)) break;
        const int item = it_ % (T / 32);
        const int r0 = item * 32, tt0 = r0 % SEQ;
        for (int i = F.tid; i < 62 * 64; i += NWAVES * 64) { const int rr = i >> 6, cc = i & 63; v4u v = (v4u){0u, 0u, 0u, 0u};
            if (tt0 + rr - 30 >= 0) v = *(const v4u*)(AGLU + (size_t)(r0 + rr - 30) * CW + cc * 8);
            *(LAS v4u*)(ain + rr * 512 + cc * 8) = v; }
        __syncthreads();
        unsigned A[31];
#pragma unroll
        for (int p2 = 0; p2 < 31; ++p2) A[p2] = (unsigned)ain[(2 * p2) * 512 + c] | ((unsigned)ain[(2 * p2 + 1) * 512 + c] << 16);
        float y[32];
#pragma unroll
        for (int R2 = 0; R2 < 16; ++R2) { float e = cb, o = cb;
#pragma unroll
            for (int q = 0; q < 16; ++q) { e = dot2c(e, A[R2 + q], wE[q]); o = dot2c(o, A[R2 + q], wO[q]); }
            asm volatile("s_nop 4" : "+v"(e), "+v"(o));
            y[2 * R2] = e; y[2 * R2 + 1] = o; }
        float s1[32], s2[32];
#pragma unroll
        for (int r = 0; r < 32; ++r) { s1[r] = y[r]; s2[r] = y[r] * y[r]; }
        tr_step<16, 32>(s1, l); tr_step<8, 32>(s1, l); tr_step<4, 32>(s1, l); tr_step<2, 32>(s1, l); tr_step<1, 32>(s1, l);
        tr_step<16, 32>(s2, l); tr_step<8, 32>(s2, l); tr_step<4, 32>(s2, l); tr_step<2, 32>(s2, l); tr_step<1, 32>(s2, l);
        float t1 = s1[0] + __shfl_xor(s1[0], 32), t2 = s2[0] + __shfl_xor(s2[0], 32);
        if (l < 32) { part[(F.wave * 32 + l) * 2] = t1; part[(F.wave * 32 + l) * 2 + 1] = t2; }
        __syncthreads();
        t1 = 0.f; t2 = 0.f;
#pragma unroll
        for (int w = 0; w < 8; ++w) { t1 += part[(w * 32 + (l & 31)) * 2]; t2 += part[(w * 32 + (l & 31)) * 2 + 1]; }
        const float mean_l = t1 * (1.f / CW), rstd_l = rsqrtf(fmaxf(t2 * (1.f / CW) - mean_l * mean_l, 0.f) + LN_EPS);
#pragma unroll
        for (int r = 0; r < 32; ++r) {
            const float mean = __builtin_bit_cast(float, __builtin_amdgcn_readlane(__builtin_bit_cast(int, mean_l), r)), rstd = __builtin_bit_cast(float, __builtin_amdgcn_readlane(__builtin_bit_cast(int, rstd_l), r));
            const float v = (y[r] - mean) * rstd * lg + lb; const float z = v * pg8::sigm(v);
            aout[r * 512 + c] = (unsigned short)(pk2(z, 0.f) & 0xffffu);
        }
        __syncthreads();
        for (int i = F.tid; i < 32 * 64; i += NWAVES * 64) { const int rr = i >> 6, cc = i & 63; *(GAS v4u*)(ALN + (size_t)(r0 + rr) * CW + cc * 8) = *(const LAS v4u*)(aout + rr * 512 + cc * 8); }
    }
    __syncthreads();
}
typedef float f32x16_t __attribute__((ext_vector_type(16)));
__device__ __forceinline__ void p6_router(Frame& F, const bf16* x1, const float* g, const float* mod, const float* b_router, int first, int stride) {
    LAS float* s_gs = (LAS float*)F.lds;
    LAS float* s_s0 = s_gs + 1024;
    LAS float* s_rstd = s_s0 + 1024;
    LAS float* s_part = s_rstd + 64;
    LAS float* s_log = s_part + 4 * 64 * 33;
    LAS int* lhist = (LAS int*)(F.lds + ROWTAB_OFF);
    if (F.tid < 32) lhist[F.tid] = 0;
    unsigned char* H8 = (unsigned char*)(F.ws + WS_H); int* TOPE = (int*)(F.ws + WS_TOPE); float* TOPG = (float*)(F.ws + WS_TOPG); int* LRANK = (int*)(F.ws + WS_LRANK); int* HIST = (int*)(F.ws + WS_HIST);
    const bf16* WRT = (const bf16*)(F.ws + WS_WRT);
    const int l = F.lane;
    const float br = b_router[F.tid & 31];
    for (int wg = first; wg < T / 64; wg += stride) {
        const int b = (wg * 64) / SEQ; const float* sh = mod + (size_t)b * NMOD * D + 3 * D; const float* sc = sh + D;
        __syncthreads();
        for (int k = F.tid; k < D; k += NWAVES * 64) { s_gs[k] = g[k] * (sc[k] + 1.f); s_s0[k] = sh[k]; }
        __syncthreads();
        f32x4 gs[4], s0[4];
#pragma unroll
        for (int j = 0; j < 4; ++j) { gs[j] = *(const LAS f32x4*)(s_gs + 256 * j + 4 * l); s0[j] = *(const LAS f32x4*)(s_s0 + 256 * j + 4 * l); }
        v2u nx[8][4];
#pragma unroll
        for (int i = 0; i < 8; ++i)
#pragma unroll
            for (int j = 0; j < 4; ++j) nx[i][j] = *(const v2u*)(x1 + (size_t)(wg * 64 + F.wave * 8 + i) * D + 256 * j + 4 * l);
#pragma unroll
        for (int i = 0; i < 8; ++i) {
            const int m = wg * 64 + F.wave * 8 + i;
            f32x4 v[4]; float ss = 0.f;
#pragma unroll
            for (int j = 0; j < 4; ++j) { const v2u w = nx[i][j]; v[j] = (f32x4){pg8::bf_lo(w.x), pg8::bf_hi(w.x), pg8::bf_lo(w.y), pg8::bf_hi(w.y)}; ss += (v[j].x * v[j].x + v[j].y * v[j].y) + (v[j].z * v[j].z + v[j].w * v[j].w); }
            const float rstd = rsqrtf(wave_sum(ss) * (1.f / D) + RMS_EPS);
            if (l == 0) s_rstd[F.wave * 8 + i] = rstd;
            GAS unsigned* o4 = (GAS unsigned*)(H8 + (size_t)m * D) + l;
#pragma unroll
            for (int j = 0; j < 4; ++j) { const f32x4 hv = v[j] * rstd * gs[j] + s0[j]; o4[64 * j] = pg8::pk4_fp8(hv.x, hv.y, hv.z, hv.w); }
        }
        __syncthreads();
        {
            const int th = F.wave & 1, kq = F.wave >> 1, r32 = l & 31, hi = l >> 5;
            const float rs = s_rstd[th * 32 + r32];
            const bf16* xa = x1 + (size_t)(wg * 64 + th * 32 + r32) * D + 256 * kq + 8 * hi;
            const bf16* wb = WRT + (size_t)r32 * D + 256 * kq + 8 * hi;
            f32x16_t acc = f32x16_t{};
#pragma unroll 4
            for (int st = 0; st < 16; ++st) {
                const v4u xw = *(const v4u*)(xa + 16 * st); const v4u wh = *(const v4u*)(wb + 16 * st), wl = *(const v4u*)(wb + NE * D + 16 * st);
                const int k0 = 256 * kq + 16 * st + 8 * hi;
                const f32x4 ga = *(const LAS f32x4*)(s_gs + k0), gb = *(const LAS f32x4*)(s_gs + k0 + 4), sa = *(const LAS f32x4*)(s_s0 + k0), sb = *(const LAS f32x4*)(s_s0 + k0 + 4);
                float hv[8];
                hv[0] = pg8::bf_lo(xw.x) * rs * ga.x + sa.x; hv[1] = pg8::bf_hi(xw.x) * rs * ga.y + sa.y; hv[2] = pg8::bf_lo(xw.y) * rs * ga.z + sa.z; hv[3] = pg8::bf_hi(xw.y) * rs * ga.w + sa.w;
                hv[4] = pg8::bf_lo(xw.z) * rs * gb.x + sb.x; hv[5] = pg8::bf_hi(xw.z) * rs * gb.y + sb.y; hv[6] = pg8::bf_lo(xw.w) * rs * gb.z + sb.z; hv[7] = pg8::bf_hi(xw.w) * rs * gb.w + sb.w;
                v4u ah, al;
                ah.x = pk2(hv[0], hv[1]); ah.y = pk2(hv[2], hv[3]); ah.z = pk2(hv[4], hv[5]); ah.w = pk2(hv[6], hv[7]);
                al.x = pk2(hv[0] - pg8::bf_lo(ah.x), hv[1] - pg8::bf_hi(ah.x)); al.y = pk2(hv[2] - pg8::bf_lo(ah.y), hv[3] - pg8::bf_hi(ah.y));
                al.z = pk2(hv[4] - pg8::bf_lo(ah.z), hv[5] - pg8::bf_hi(ah.z)); al.w = pk2(hv[6] - pg8::bf_lo(ah.w), hv[7] - pg8::bf_hi(ah.w));
                const pg8::bf16x8 Ah = __builtin_bit_cast(pg8::bf16x8, ah), Al = __builtin_bit_cast(pg8::bf16x8, al), Bh = __builtin_bit_cast(pg8::bf16x8, wh), Bl = __builtin_bit_cast(pg8::bf16x8, wl);
                acc = __builtin_amdgcn_mfma_f32_32x32x16_bf16(Ah, Bh, acc, 0, 0, 0);
                acc = __builtin_amdgcn_mfma_f32_32x32x16_bf16(Ah, Bl, acc, 0, 0, 0);
                acc = __builtin_amdgcn_mfma_f32_32x32x16_bf16(Al, Bh, acc, 0, 0, 0);
            }
#pragma unroll
            for (int r = 0; r < 16; ++r) { const int tok = th * 32 + (r & 3) + 8 * (r >> 2) + 4 * hi; s_part[(kq * 64 + tok) * 33 + r32] = acc[r]; }
        }
        __syncthreads();
        for (int i = F.tid; i < 64 * 32; i += NWAVES * 64) { const int tok = i >> 5, e = i & 31;
            s_log[tok * 33 + e] = (s_part[(0 * 64 + tok) * 33 + e] + s_part[(1 * 64 + tok) * 33 + e]) + (s_part[(2 * 64 + tok) * 33 + e] + s_part[(3 * 64 + tok) * 33 + e]) + br; }
        __syncthreads();
#pragma unroll 1
        for (int grp = 0; grp < 4; ++grp) {
            const int row = l >> 5, e0 = l & 31, tk = F.wave * 8 + grp * 2 + row, m0 = wg * 64 + F.wave * 8 + grp * 2;
            float l0 = s_log[tk * 33 + e0];
            float tv[4]; int te[4];
#pragma unroll
            for (int k = 0; k < 4; ++k) {
                float bv = l0; int bi = e0;
#pragma unroll
                for (int st = 0; st < 4; ++st) { const float ov = dppf(bv, st); const int oi = dppi(bi, st); if (ov > bv || (ov == bv && oi < bi)) { bv = ov; bi = oi; } }
                { const float ov = __shfl_xor(bv, 16); const int oi = __shfl_xor(bi, 16); if (ov > bv || (ov == bv && oi < bi)) { bv = ov; bi = oi; } }
                tv[k] = bv; te[k] = bi;
                if (bi == e0) l0 = -INFINITY;
            }
            if ((l & 31) == 0) {
                const float e1 = expf(tv[1] - tv[0]), e2 = expf(tv[2] - tv[0]), e3 = expf(tv[3] - tv[0]); const float inv = 1.f / (1.f + e1 + e2 + e3);
                const int t = m0 + row;
                *(int4*)(TOPE + t * 4) = make_int4(te[0], te[1], te[2], te[3]);
                *(float4*)(TOPG + t * 4) = make_float4(inv, e1 * inv, e2 * inv, e3 * inv);
                int4 rk; rk.x = __hip_atomic_fetch_add(&lhist[te[0]], 1, __ATOMIC_RELAXED, __HIP_MEMORY_SCOPE_WORKGROUP); rk.y = __hip_atomic_fetch_add(&lhist[te[1]], 1, __ATOMIC_RELAXED, __HIP_MEMORY_SCOPE_WORKGROUP); rk.z = __hip_atomic_fetch_add(&lhist[te[2]], 1, __ATOMIC_RELAXED, __HIP_MEMORY_SCOPE_WORKGROUP); rk.w = __hip_atomic_fetch_add(&lhist[te[3]], 1, __ATOMIC_RELAXED, __HIP_MEMORY_SCOPE_WORKGROUP);
                *(int4*)(LRANK + t * 4) = rk;
            }
        }
        __syncthreads();
        { const int t2 = F.wave * 64 + fresh_lane();
          if (t2 < 32) { HIST[wg * 32 + t2] = lhist[t2]; lhist[t2] = 0; } }
        __syncthreads();
    }
}
__device__ __forceinline__ void p7_slots(Frame& F) {
    LAS int* s_tot = (LAS int*)F.lds; LAS int* s_pre = s_tot + 32; LAS int* s_tstart = s_tot + 64; LAS int* s_nt = s_tot + 128;
    const int* HIST = (const int*)(F.ws + WS_HIST); const int* TOPE = (const int*)(F.ws + WS_TOPE); const int* LRANK = (const int*)(F.ws + WS_LRANK);
    int* SLOT_TOK = (int*)(F.ws + WS_SLOT_TOK); int* TOK_SLOT = (int*)(F.ws + WS_TOK_SLOT); int* TILE_E = (int*)(F.ws + WS_TILE_E);
    constexpr int NBLK = T / 64;
    for (int wg = blockIdx.x; wg < NBLK; wg += F.G) {
        __syncthreads();
        if (F.tid < 256) {
            const int e = F.tid >> 3, sub = F.tid & 7; int tot = 0, pre = 0;
            for (int w = sub; w < NBLK; w += 8) { const int hcount = HIST[w * 32 + e]; tot += hcount; if (w < wg) pre += hcount; }
            tot += __shfl_xor(tot, 1); tot += __shfl_xor(tot, 2); tot += __shfl_xor(tot, 4); pre += __shfl_xor(pre, 1); pre += __shfl_xor(pre, 2); pre += __shfl_xor(pre, 4);
            if (sub == 0) { s_tot[e] = tot; s_pre[e] = pre; s_nt[e] = (tot + 255) >> 8; }
        }
        __syncthreads();
        if (F.tid == 0) { int s = 0; for (int e = 0; e < NE; ++e) { s_tstart[e] = s; s += s_nt[e]; } s_tstart[32] = s; }
        __syncthreads();
        if (F.tid < 256) { const int idx = wg * 256 + F.tid; const int e = TOPE[idx]; const int slot = 256 * s_tstart[e] + s_pre[e] + LRANK[idx]; TOK_SLOT[idx] = slot; SLOT_TOK[slot] = idx >> 2; }
        if (wg < NE) { const int e = wg; const int lo = 256 * s_tstart[e] + s_tot[e], hi = 256 * (s_tstart[e] + s_nt[e]); for (int s = lo + F.tid; s < hi; s += NWAVES * 64) SLOT_TOK[s] = 0; }
        if (wg == 0) { if (F.tid < NE) { for (int i = 0; i < s_nt[F.tid]; ++i) TILE_E[16 + s_tstart[F.tid] + i] = F.tid; } if (F.tid == 0) TILE_E[0] = s_tstart[32]; }
    }
    __syncthreads();
}
__device__ __forceinline__ void p10_final(Frame& F, const float* mod, const float* final_g, float* out) {
    const bf16* X1 = (const bf16*)(F.ws + WS_X1); const unsigned char* YB = (const unsigned char*)(F.ws + WS_YB); const int* TOK_SLOT = (const int*)(F.ws + WS_TOK_SLOT); const float* TOPG = (const float*)(F.ws + WS_TOPG);
    const int gw = F.vcu * NWAVES + F.wave, NGW = F.G * NWAVES, l = fresh_lane();
    typedef float f2_t __attribute__((ext_vector_type(2)));
    f32x4 fgv[2][2];
#pragma unroll
    for (int j = 0; j < 2; ++j)
#pragma unroll
        for (int q = 0; q < 2; ++q) fgv[j][q] = *(const f32x4*)(final_g + 512 * j + 8 * l + 4 * q);
    for (int m0 = gw; m0 < T; m0 += 8 * NGW) {
        int4 slv[8]; float4 gtv[8];
#pragma unroll
        for (int i = 0; i < 8; ++i) { const int m = m0 + i * NGW, mm = m < T ? m : m0; slv[i] = *(const int4*)(TOK_SLOT + mm * 4); gtv[i] = *(const float4*)(TOPG + mm * 4); }
        v2u a[2][4][2]; v4u xw[2][2];
#define P10_ISSUE(i_) do { const int p_ = (i_) & 1, m_ = (m0 + (i_) * NGW < T) ? m0 + (i_) * NGW : m0; const int s_[4] = {slv[i_].x, slv[i_].y, slv[i_].z, slv[i_].w}; \
        _Pragma("unroll") for (int k = 0; k < 4; ++k) _Pragma("unroll") for (int j = 0; j < 2; ++j) a[p_][k][j] = __builtin_nontemporal_load((const v2u*)(YB + (size_t)s_[k] * DE + 512 * j + 8 * l));     \
        _Pragma("unroll") for (int j = 0; j < 2; ++j) xw[p_][j] = __builtin_nontemporal_load((const v4u*)(X1 + (size_t)m_ * D + 512 * j + 8 * l)); } while (0)
        P10_ISSUE(0);
#pragma unroll
        for (int i = 0; i < 8; ++i) {
            const int m = m0 + i * NGW, p = i & 1;
            if (i + 1 < 8) P10_ISSUE(i + 1);
            if (m < T) {
                const int b = m / SEQ; const float* g2 = mod + (size_t)b * NMOD * D + 5 * D;
                const float g4[4] = {gtv[i].x, gtv[i].y, gtv[i].z, gtv[i].w};
                float y[16];
#pragma unroll
                for (int q = 0; q < 16; ++q) y[q] = 0.f;
#pragma unroll
                for (int k = 0; k < 4; ++k)
#pragma unroll
                    for (int j = 0; j < 2; ++j) { const v2u av = a[p][k][j];
                        const f2_t f01 = __builtin_amdgcn_cvt_pk_f32_fp8((int)av.x, false), f23 = __builtin_amdgcn_cvt_pk_f32_fp8((int)av.x, true), f45 = __builtin_amdgcn_cvt_pk_f32_fp8((int)av.y, false), f67 = __builtin_amdgcn_cvt_pk_f32_fp8((int)av.y, true);
                        y[8 * j + 0] += g4[k] * f01.x; y[8 * j + 1] += g4[k] * f01.y; y[8 * j + 2] += g4[k] * f23.x; y[8 * j + 3] += g4[k] * f23.y;
                        y[8 * j + 4] += g4[k] * f45.x; y[8 * j + 5] += g4[k] * f45.y; y[8 * j + 6] += g4[k] * f67.x; y[8 * j + 7] += g4[k] * f67.y; }
                float ss = 0.f;
#pragma unroll
                for (int j = 0; j < 2; ++j) { const v4u xv = xw[p][j];
                    const float xf[8] = {pg8::bf_lo(xv.x), pg8::bf_hi(xv.x), pg8::bf_lo(xv.y), pg8::bf_hi(xv.y), pg8::bf_lo(xv.z), pg8::bf_hi(xv.z), pg8::bf_lo(xv.w), pg8::bf_hi(xv.w)};
#pragma unroll
                    for (int q = 0; q < 2; ++q) { const int k0 = 512 * j + 8 * l + 4 * q; const f32x4 gv = *(const f32x4*)(g2 + k0);
                        y[8 * j + 4 * q + 0] = xf[4 * q + 0] + gv.x * y[8 * j + 4 * q + 0]; y[8 * j + 4 * q + 1] = xf[4 * q + 1] + gv.y * y[8 * j + 4 * q + 1]; y[8 * j + 4 * q + 2] = xf[4 * q + 2] + gv.z * y[8 * j + 4 * q + 2]; y[8 * j + 4 * q + 3] = xf[4 * q + 3] + gv.w * y[8 * j + 4 * q + 3];
                        ss += (y[8 * j + 4 * q] * y[8 * j + 4 * q] + y[8 * j + 4 * q + 1] * y[8 * j + 4 * q + 1]) + (y[8 * j + 4 * q + 2] * y[8 * j + 4 * q + 2] + y[8 * j + 4 * q + 3] * y[8 * j + 4 * q + 3]); } }
                const float rstd = rsqrtf(wave_sum(ss) * (1.f / D) + RMS_EPS);
#pragma unroll
                for (int j = 0; j < 2; ++j)
#pragma unroll
                    for (int q = 0; q < 2; ++q) { const int k0 = 512 * j + 8 * l + 4 * q; const f32x4 fg = fgv[j][q];
                        f32x4 o; o.x = y[8 * j + 4 * q] * rstd * fg.x; o.y = y[8 * j + 4 * q + 1] * rstd * fg.y; o.z = y[8 * j + 4 * q + 2] * rstd * fg.z; o.w = y[8 * j + 4 * q + 3] * rstd * fg.w;
                        *(GAS f32x4*)(out + (size_t)m * D + k0) = o; }
            }
        }
#undef P10_ISSUE
    }
}
__global__ void __launch_bounds__(NWAVES * 64, 2) mk_fwd(Args args) {
    extern __shared__ __attribute__((aligned(16))) unsigned char lds[];
    Frame F;
    F.lds = (LAS unsigned char*)lds; F.ws = args.ws;
    F.tid = threadIdx.x; F.lane = F.tid & 63; F.wave = __builtin_amdgcn_readfirstlane(F.tid >> 6);
    F.G = gridDim.x; { const int bx = blockIdx.x; F.vcu = (F.G % 8 == 0) ? (bx % 8) * (F.G / 8) + bx / 8 : bx; }
    volatile LAS unsigned* MISC = (volatile LAS unsigned*)(F.lds + MISC_OFF);
    for (int u = F.tid; u < (ROWTAB_OFF - LDSCTL_OFF) / 4; u += NWAVES * 64) ((LAS unsigned*)(F.lds + LDSCTL_OFF))[u] = 0u;
    __syncthreads();
    XcdBarrier bar; bar.bar = (unsigned*)(args.ws + WS_CTL) + CW_BAR; bar.x = 0; bar.st = nullptr;
    if (MK_N_LAUNCHES == 1) bar = xcd_barrier_post((unsigned*)(args.ws + WS_CTL) + CW_BAR, MISC + 8);
    const int lo = args.ph_lo, hi = args.ph_hi;
#define IN(k) (lo <= (k) && (k) < hi)
#define SEAM(k) do { if (IN(k) && IN((k) + 1)) xcd_barrier(bar); } while (0)
    const float* x = args.in[0]; const float* mod = (const float*)(args.ws + WS_MOD);
    unsigned char* ws = args.ws;

    f32x4 p1pre[4] = {};
    if (IN(0)) { { p0_mod(F, args.in[1], args.in[2], args.in[3], (float*)(ws + WS_MOD)); p0_router_w(F, args.in[15]); p0_convert(F, args.in[5], args.in[11], args.in[12], args.in[13], args.in[17], args.in[19]); }
                 if (IN(1)) { __syncthreads(); p1_stage_wf(F, args.in[5]);
                     const int m0_ = (F.vcu * NWAVES + F.wave) * 8;
                     if (m0_ < T) {
#pragma unroll
                         for (int j = 0; j < 4; ++j) p1pre[j] = __builtin_nontemporal_load((const f32x4*)(x + (size_t)m0_ * D + 256 * j + 4 * F.lane)); } }
                 SEAM(0); }
    if (IN(1)) { { p1_norm1(F, x, args.in[4], mod, args.in[5], args.in[6], IN(0), p1pre); } SEAM(1); }
    if (IN(2)) { {
        for (int bh = blockIdx.x; bh < BATCH * NH; bh += F.G) p2_fscan(F, bh);
        pg8::DenseSched S; S.init(ws + WS_H, ws + WS_WIN, T, NIN, D / 2, F.G, (int)blockIdx.x);
        static_assert(WS_K - WS_Q == WS_V - WS_K, "q|k|v spacing");
        pg8::EpiIn E{(bf16*)(ws + WS_AGLU), (bf16*)(ws + WS_Q), (bf16*)(ws + WS_SGC), (WS_K - WS_Q) / 2, (WS_SGA - WS_SGC) / 2, attn_body::C2, (unsigned*)(ws + WS_CTL + CTL_NORM), SEQ, 0.03125f};
        pg8::gemm_phase8<pg8::EpiIn, pg8::DenseSched, true>(F.lds, D / 2, S, E); }
        phase_main_done(F, 2); cvt_fill(F, args.in[17], args.in[19], 2, MISC);
        SEAM(2);
    }
    if (IN(3)) {
        static_assert(attn_body::ATTN_LDS_BYTES <= RING_BYTES, "attention LDS");
        const attn_body::AttnTensors AT{(const attn_body::bf16*)(ws + WS_Q), (const attn_body::bf16*)(ws + WS_K), (const attn_body::bf16*)(ws + WS_V), (const unsigned*)(ws + WS_KX), (attn_body::bf16*)(ws + WS_ATT)};
        const attn_body::AttnQueue AQ{(unsigned*)(ws + WS_CTL + CTL_QCTR), (const float*)(ws + WS_BIAS), (const float*)(ws + WS_CTL + CTL_NORM), 512};
        attn_body::attn_phase<8>((char*)lds, MISC, AT, AQ);
        p3_conv(F, args.in[7], args.in[8], args.in[9], args.in[10], MISC, 1);
        phase_main_done(F, 3); cvt_fill(F, args.in[17], args.in[19], 3, MISC);
        SEAM(3);
    }
    if (IN(4)) { {
        pg8::PairSched S{(const char*)(ws + WS_ALN), (const char*)(ws + WS_WC), (const char*)(ws + WS_ATT), (const char*)(ws + WS_WA), CW, T / 256, D / 256, (T / 256) * (D / 256), F.G, (int)blockIdx.x};
        pg8::EpiMix E{(const bf16*)(ws + WS_SGC), (WS_SGA - WS_SGC) / 2, (bf16*)(ws + WS_MIX)};
        pg8::gemm_phase<pg8::EpiMix, pg8::PairSched, true>(F.lds, CW, S, E); }
        SEAM(4);
    }
    if (IN(5)) { {
        pg8::DenseSched S; S.init(ws + WS_MIX, ws + WS_WO, T, D, D, F.G, (int)blockIdx.x);
        pg8::EpiRes E{x, mod + 2 * D, (bf16*)(ws + WS_X1), SEQ, NMOD * D};
        pg8::gemm_phase<pg8::EpiRes, pg8::DenseSched, false>(F.lds, D, S, E); }
        SEAM(5);
    }
    if (IN(6)) { { const int nr = (F.G + 1) / 2; if ((blockIdx.x & 1) == 0) p6_router(F, (const bf16*)(ws + WS_X1), args.in[14], mod, args.in[16], (int)(blockIdx.x >> 1), nr); }
                 cvt_fill(F, args.in[17], args.in[19], 0, MISC); SEAM(6); }
    if (IN(7)) { { p7_slots(F); } SEAM(7); }
    if (IN(8)) { {
        const int* TILE_E = (const int*)(ws + WS_TILE_E); const int ntiles = TILE_E[0]; const int Wd = (F.G % 8 == 0) ? F.G / 8 : F.G, NG = (F.G % 8 == 0) ? 8 : 1;
        LAS int* rows = (LAS int*)(F.lds + ROWTAB_OFF);
        pg8::MoeSched<8, true> S{(const char*)(ws + WS_H), (const char*)(ws + WS_W1), TILE_E + 16, D / 2, 8 * ntiles, (8 * ntiles + NG - 1) / NG, F.vcu / Wd, F.vcu % Wd, Wd, (size_t)2 * DE * D, rows};
        const int* SLOT_TOK = (const int*)(ws + WS_SLOT_TOK);
        for (int i = 0; i < ROWTAB_UNITS; ++i) { pg8::Unit u; if (!S.next(i, u)) break; if (F.tid < 256) rows[i * 256 + F.tid] = SLOT_TOK[u.pm * 256 + F.tid]; }
        __syncthreads();
        pg8::EpiSwiglu8 E{args.in[18], (unsigned char*)(ws + WS_HM)};
        pg8::gemm_phase8<pg8::EpiSwiglu8, pg8::MoeSched<8, true>, true>(F.lds, D / 2, S, E); }
        SEAM(8);
    }
    if (IN(9)) { {
        const int* TILE_E = (const int*)(ws + WS_TILE_E); const int ntiles = TILE_E[0]; const int Wd = (F.G % 8 == 0) ? F.G / 8 : F.G, NG = (F.G % 8 == 0) ? 8 : 1;
        pg8::MoeSched<4, false> S{(const char*)(ws + WS_HM), (const char*)(ws + WS_W2), TILE_E + 16, DE / 2, 4 * ntiles, (4 * ntiles + NG - 1) / NG, F.vcu / Wd, F.vcu % Wd, Wd, (size_t)D * DE, nullptr};
        pg8::EpiYb8 E{args.in[20], (bf16*)(ws + WS_YB)};
        pg8::gemm_phase8<pg8::EpiYb8, pg8::MoeSched<4, false>, true>(F.lds, DE / 2, S, E); }
        SEAM(9);
    }
    if (IN(10)) { { p10_final(F, mod, args.in[21], args.out); } }
#undef IN
#undef SEAM
}

extern "C" void kernel_launch(void* const* d_in, const int* in_sizes, int n_in, void* d_out, int out_size, void* d_ws, size_t ws_size, hipStream_t stream) {
    static int grid = 0;
    if (grid == 0) {
        if (n_in != 22 || in_sizes[0] != T * D || out_size != T * D || ws_size < WS_END) { fprintf(stderr, "kernel_launch: unexpected shapes / workspace (n_in %d, ws %zu); nothing launched\n", n_in, ws_size); grid = -1; return; }
        int dev = 0, cus = 0, per_cu = 0;
        if (hipGetDevice(&dev) != hipSuccess || hipDeviceGetAttribute(&cus, hipDeviceAttributeMultiprocessorCount, dev) != hipSuccess) { grid = -1; return; }
        if (hipFuncSetAttribute((const void*)mk_fwd, hipFuncAttributeMaxDynamicSharedMemorySize, LDS_BYTES) != hipSuccess) { fprintf(stderr, "kernel_launch: hipFuncSetAttribute failed\n"); grid = -1; return; }
        if (hipOccupancyMaxActiveBlocksPerMultiprocessor(&per_cu, (const void*)mk_fwd, NWAVES * 64, LDS_BYTES) != hipSuccess || per_cu < 1) fprintf(stderr, "kernel_launch: occupancy query reports %d\n", per_cu);
        (void)hipGetLastError();
        grid = cus;
    }
    if (grid < 0) return;
    if (hipMemsetAsync((char*)d_ws + WS_CTL, 0, CTL_ZERO_BYTES, stream) != hipSuccess) return;
    Args a{};
    for (int i = 0; i < 22; ++i) a.in[i] = (const float*)d_in[i];
    a.out = (float*)d_out; a.ws = (unsigned char*)d_ws;
    if (MK_N_LAUNCHES == 1) { a.ph_lo = 0; a.ph_hi = NPH; hipLaunchKernelGGL(mk_fwd, dim3(grid), dim3(NWAVES * 64), LDS_BYTES, stream, a); }
    else for (int p = 0; p < NPH; ++p) { a.ph_lo = p; a.ph_hi = p + 1; hipLaunchKernelGGL(mk_fwd, dim3(grid), dim3(NWAVES * 64), LDS_BYTES, stream, a); }
}
```
